# Optimizing an MI355X kernel written in HIP

```python
import math
import jax, jax.numpy as jnp
from jax import lax
import numpy as np

D_MODEL = 2048
BATCH = 4
SEQ = 4096
DEPTH = 1

D_MIX = D_MODEL
ATTN_W = D_MIX // 2
SSM_W = D_MIX - ATTN_W
HEAD_DIM = 64
N_HEADS = ATTN_W // HEAD_DIM
N_KV_HEADS = 4
KV_REP = N_HEADS // N_KV_HEADS
KV_W = N_KV_HEADS * HEAD_DIM
WINDOW = 128
BLOCK = 128
ROPE_THETA = 10000.0
SSM_H = 16
SSM_G = SSM_W // SSM_H
SSM_P = 64
SSM_CHUNK = 128
DT_MIN = 1e-3
DT_MAX = 1e-1
NORM_EPS = 1e-6
IN_W = ATTN_W + 2 * KV_W + ATTN_W + SSM_W + SSM_W

kernel_name = "hymba_swa_sink_s5_hybrid"


def rms_norm(x, w):
    xf = x.astype(jnp.float32)
    y = xf * lax.rsqrt(jnp.mean(xf * xf, axis=-1, keepdims=True) + NORM_EPS)
    return (y * w.astype(jnp.float32)).astype(x.dtype)


def rope_tables(positions):
    inv_freq = ROPE_THETA ** (-jnp.arange(0, HEAD_DIM, 2, dtype=jnp.float32) / HEAD_DIM)
    ang = positions.astype(jnp.float32)[..., None] * inv_freq
    return jnp.cos(ang)[:, :, None, :], jnp.sin(ang)[:, :, None, :]


def apply_rope(t, cos, sin):
    tf = t.astype(jnp.float32)
    t1, t2 = tf[..., : HEAD_DIM // 2], tf[..., HEAD_DIM // 2 :]
    out = jnp.concatenate([t1 * cos - t2 * sin, t2 * cos + t1 * sin], axis=-1)
    return out.astype(t.dtype)


def swa_sink_attention(q, k, v, positions, q_norm_w, k_norm_w, sinks):
    B, L = q.shape[0], q.shape[1]
    nb = L // BLOCK
    q = q.reshape(B, L, N_HEADS, HEAD_DIM)
    k = k.reshape(B, L, N_KV_HEADS, HEAD_DIM)
    v = v.reshape(B, L, N_KV_HEADS, HEAD_DIM)
    cos, sin = rope_tables(positions)
    q = apply_rope(rms_norm(q, q_norm_w), cos, sin)
    k = apply_rope(rms_norm(k, k_norm_w), cos, sin)

    qb = q.reshape(B, nb, BLOCK, N_KV_HEADS, KV_REP, HEAD_DIM)

    def with_prev(t):
        t = t.reshape(B, nb, BLOCK, N_KV_HEADS, HEAD_DIM)
        prev = jnp.pad(t[:, :-1], ((0, 0), (1, 0), (0, 0), (0, 0), (0, 0)))
        return jnp.concatenate([prev, t], axis=2)

    kb, vb = with_prev(k), with_prev(v)
    scale = 1.0 / math.sqrt(HEAD_DIM)
    s = jnp.einsum('bnqgrd,bnkgd->bngrqk', qb, kb).astype(jnp.float32) * scale

    qi = jnp.arange(BLOCK)[:, None] + BLOCK
    ki = jnp.arange(2 * BLOCK)[None, :]
    rel = qi - ki
    band = (rel >= 0) & (rel < WINDOW)
    has_prev = (jnp.arange(nb)[:, None, None] > 0) | (ki >= BLOCK)[None]
    mask = band[None] & has_prev
    s = jnp.where(mask[None, :, None, None], s, jnp.float32(-1e30))

    sink = jnp.broadcast_to(
        sinks.astype(jnp.float32).reshape(1, 1, N_KV_HEADS, KV_REP, 1, 1),
        s.shape[:-1] + (1,))
    p = jax.nn.softmax(jnp.concatenate([s, sink], axis=-1), axis=-1)[..., :-1]
    o = jnp.einsum('bngrqk,bnkgd->bnqgrd', p.astype(vb.dtype), vb)
    return o.reshape(B, L, ATTN_W)


def s5_ssm(u, a_re, a_im, log_step, b_re, b_im, c_re, c_im, d_skip):
    B, L = u.shape[0], u.shape[1]
    nc = L // SSM_CHUNK
    f32 = jnp.float32
    lam = lax.complex(a_re.astype(f32), a_im.astype(f32))
    delta = jnp.exp(log_step.astype(f32))[:, None]
    lam_bar = jnp.exp(lam * delta)
    b = lax.complex(b_re.astype(f32), b_im.astype(f32))
    b_bar = ((lam_bar - 1.0) / lam)[..., None] * b
    c = lax.complex(c_re.astype(f32), c_im.astype(f32))

    uf = u.astype(f32)
    ug = uf.reshape(B, nc, SSM_CHUNK, SSM_G, SSM_H).transpose(1, 0, 2, 3, 4)

    def combine(left, right):
        a_l, x_l = left
        a_r, x_r = right
        return a_r * a_l, a_r * x_l + x_r

    def chunk_step(h0, u_c):
        bu = jnp.einsum('gph,bigh->bigp', b_bar, u_c.astype(jnp.complex64))
        a = jnp.broadcast_to(lam_bar, bu.shape)
        a_cum, h_loc = lax.associative_scan(combine, (a, bu), axis=1)
        h = h_loc + a_cum * h0[:, None]
        y = jnp.einsum('ghp,bigp->bigh', c, h).real
        return h[:, -1], y

    h0 = jnp.zeros((B, SSM_G, SSM_P), jnp.complex64)
    _, ys = lax.scan(chunk_step, h0, ug)
    y = ys.transpose(1, 0, 2, 3, 4).reshape(B, L, SSM_W)
    return y + d_skip.astype(f32) * uf


def setup_inputs(seed: int = 0) -> dict:
    key = jax.random.key(seed)
    ks = jax.random.split(key, 20)
    f32 = jnp.float32
    x = jax.random.normal(ks[0], (BATCH, SEQ, D_MODEL), f32)
    offs = jax.random.randint(ks[1], (BATCH, 1), 0, 1024, dtype=jnp.int32)
    positions = (jnp.arange(SEQ, dtype=jnp.int32)[None, :] + offs).astype(jnp.int32)
    norm_w = 1.0 + 0.02 * jax.random.normal(ks[2], (D_MODEL,), f32)
    w_in = jax.random.normal(ks[3], (D_MODEL, IN_W), f32) * D_MODEL ** -0.5
    q_norm_w = 1.0 + 0.02 * jax.random.normal(ks[4], (HEAD_DIM,), f32)
    k_norm_w = 1.0 + 0.02 * jax.random.normal(ks[5], (HEAD_DIM,), f32)
    sinks = jax.random.normal(ks[6], (N_HEADS,), f32)
    n = jnp.arange(SSM_P, dtype=f32)[None, :]
    a_re = -0.5 + 0.01 * jax.random.normal(ks[7], (SSM_G, SSM_P), f32)
    a_im = math.pi * n + 0.01 * jax.random.normal(ks[8], (SSM_G, SSM_P), f32)
    log_step = jax.random.uniform(ks[9], (SSM_G,), f32, math.log(DT_MIN), math.log(DT_MAX))
    b_scale = (2.0 * SSM_H) ** -0.5
    b_re = jax.random.normal(ks[10], (SSM_G, SSM_P, SSM_H), f32) * b_scale
    b_im = jax.random.normal(ks[11], (SSM_G, SSM_P, SSM_H), f32) * b_scale
    c_scale = (2.0 * SSM_P) ** -0.5
    c_re = jax.random.normal(ks[12], (SSM_G, SSM_H, SSM_P), f32) * c_scale
    c_im = jax.random.normal(ks[13], (SSM_G, SSM_H, SSM_P), f32) * c_scale
    d_skip = jax.random.normal(ks[14], (SSM_W,), f32)
    w_glu = jax.random.normal(ks[15], (SSM_W, SSM_W), f32) * SSM_W ** -0.5
    b_glu = 0.02 * jax.random.normal(ks[16], (SSM_W,), f32)
    attn_out_norm_w = 1.0 + 0.02 * jax.random.normal(ks[17], (ATTN_W,), f32)
    ssm_out_norm_w = 1.0 + 0.02 * jax.random.normal(ks[18], (SSM_W,), f32)
    w_out = jax.random.normal(ks[19], (D_MIX, D_MODEL), f32) * D_MIX ** -0.5
    return {"x": x, "positions": positions, "norm_w": norm_w, "w_in": w_in,
            "q_norm_w": q_norm_w, "k_norm_w": k_norm_w, "sinks": sinks,
            "a_re": a_re, "a_im": a_im, "log_step": log_step,
            "b_re": b_re, "b_im": b_im, "c_re": c_re, "c_im": c_im,
            "d_skip": d_skip, "w_glu": w_glu, "b_glu": b_glu,
            "attn_out_norm_w": attn_out_norm_w, "ssm_out_norm_w": ssm_out_norm_w,
            "w_out": w_out}


def reference(x, positions, norm_w, w_in, q_norm_w, k_norm_w, sinks,
              a_re, a_im, log_step, b_re, b_im, c_re, c_im, d_skip, w_glu, b_glu,
              attn_out_norm_w, ssm_out_norm_w, w_out):
    for _ in range(DEPTH):
        h = rms_norm(x, norm_w)
        proj = jnp.einsum('bld,de->ble', h, w_in)
        splits = np.cumsum([ATTN_W, KV_W, KV_W, ATTN_W, SSM_W])
        q, k, v, z_attn, u, z_ssm = jnp.split(proj, splits, axis=-1)

        o_attn = swa_sink_attention(q, k, v, positions, q_norm_w, k_norm_w, sinks)
        o_attn = o_attn * jax.nn.silu(z_attn)

        y = s5_ssm(u, a_re, a_im, log_step, b_re, b_im, c_re, c_im, d_skip)
        y = jax.nn.gelu(y)
        y = y * jax.nn.sigmoid(y @ w_glu.astype(jnp.float32) + b_glu.astype(jnp.float32))
        o_ssm = y.astype(x.dtype) * jax.nn.silu(z_ssm)

        merged = jnp.concatenate([rms_norm(o_attn, attn_out_norm_w),
                                  rms_norm(o_ssm, ssm_out_norm_w)], axis=-1)
        x = x + jnp.einsum('ble,ed->bld', merged, w_out).astype(x.dtype)
    return x
```

```cpp
#include <hip/hip_runtime.h>
#include <cstdio>
#include <cstdint>

constexpr int BATCH = 4, SEQ = 4096, DM = 2048, M = BATCH * SEQ;
constexpr int AW = 1024, KVW = 256, SW = 1024, INW = 4608, HD = 64, NH = 16, NKV = 4;
constexpr int SG = 64, SH = 16, SP = 64;
constexpr float EPS = 1e-6f;
constexpr int TAB_OFF = 131072 + 1024;

namespace pg8 {
#define PG8_LAS __attribute__((address_space(3)))
typedef unsigned short bf16_t;
typedef short bf16x8 __attribute__((ext_vector_type(8)));
typedef float f32x4 __attribute__((ext_vector_type(4)));
typedef unsigned u32x4 __attribute__((ext_vector_type(4)));
constexpr int BM = 256, BK = 64, HALF = 128, HTB = HALF * BK * 2  , STAGE_BYTES = 8 * HTB, NXCD = 8, WGM = 8;

__host__ __device__ __forceinline__ int lds_byte(int r, int c) { const int st = (r >> 4) * 2 + (c >> 5), rr = r & 15, cc = c & 31, ob = rr * 64 + cc * 2; return st * 1024 + (ob ^ (((ob >> 9) & 1) << 5)); }
__host__ __device__ __forceinline__ void stage_rc(int b, int& R, int& C) { const int st = b / 1024, sb = b % 1024, swz = sb ^ (((sb >> 9) & 1) << 5); R = (st >> 1) * 16 + swz / 64; C = (st & 1) * 32 + (swz % 64) / 2; }
__host__ __device__ __forceinline__ int perm32(int rho) { const int n = rho >> 4, i = rho & 15; return 8 * (i >> 2) + 4 * n + (i & 3); }

struct Unit { int pm, pn; };
struct Gemm { const bf16_t* A; const bf16_t* Bt; int M, N, K; };

struct StaticOrder {
    int nM, nN, nwg, G, c;
    __host__ __device__ void init(int M, int N, int G_, int c_) { nM = M / BM; nN = N / BM; nwg = nM * nN; G = G_; c = c_; }
    __host__ __device__ bool next(int i, Unit& u) const {
        const long L = (long)i * G + c; if (L >= nwg) return false;
        int wgid = (int)L; { const int q = nwg / NXCD, r = nwg % NXCD, xcd = wgid % NXCD, off = wgid / NXCD; wgid = (xcd < r ? xcd * (q + 1) : r * (q + 1) + (xcd - r) * q) + off; }
        const int nig = WGM * nN, gid = wgid / nig, fm = gid * WGM, gsz = (nM - fm) < WGM ? (nM - fm) : WGM;
        u.pm = fm + ((wgid % nig) % gsz); u.pn = (wgid % nig) / gsz; return true;
    }
    __device__ __forceinline__ void a_ready(const Unit&) const {}
    __device__ __forceinline__ void done(const Unit&) const {}
};

__device__ __forceinline__ unsigned cvt_pk_bf16(float lo, float hi) { unsigned r; asm volatile("v_cvt_pk_bf16_f32 %0, %1, %2" : "=v"(r) : "v"(lo), "v"(hi)); return r; }
typedef float f32x2 __attribute__((ext_vector_type(2)));
__device__ __forceinline__ float bf_lo(unsigned w) { return __uint_as_float(w << 16); }
__device__ __forceinline__ float bf_hi(unsigned w) { return __uint_as_float(w & 0xffff0000u); }
__device__ __forceinline__ float sigmoidf_(float x) { return __builtin_amdgcn_rcpf(1.0f + __expf(-x)); }

struct EpiProj {
    static constexpr bool PERM = true, AFTER_DRAIN = false, HAS_MID = false;
    bf16_t *Q, *Kb, *Vb, *ZA, *U, *ZS;
    __device__ __forceinline__ void mid(f32x4 (&acc)[2][2][4][2], const Unit&, int, int, int, int, int, PG8_LAS unsigned char*) const {}
    __device__ __forceinline__ void operator()(const f32x4 (&acc)[2][2][4][2], const Unit& u, int ui, int wr, int wc, int fr, int fq, PG8_LAS unsigned char* lds) const {
        const int row0 = u.pm * BM + wr * 64 + fr; const int pn = u.pn;
        bf16_t* base; int ldc, colt; bool isU = false;
        if (pn < 4) { base = Q; ldc = 1024; colt = pn * 256; }
        else if (pn == 4) { base = Kb; ldc = 256; colt = 0; }
        else if (pn == 5) { base = Vb; ldc = 256; colt = 0; }
        else if (pn < 10) { base = ZA; ldc = 1024; colt = (pn - 6) * 256; }
        else if (pn < 14) { base = U; ldc = 1024; colt = (pn - 10) * 256; isU = true; }
        else { base = ZS; ldc = 1024; colt = (pn - 14) * 256; }
        const int col0 = colt + wc * 32 + 8 * fq;
#pragma unroll
        for (int ai = 0; ai < 2; ++ai)
#pragma unroll
            for (int m = 0; m < 4; ++m) { const int row = row0 + ai * HALF + m * 16;
#pragma unroll
                for (int bj = 0; bj < 2; ++bj) { const f32x4 v0 = acc[ai][bj][m][0], v1 = acc[ai][bj][m][1]; const int col = col0 + bj * HALF;
                    u32x4 w; w.x = cvt_pk_bf16(v0[0], v0[1]); w.y = cvt_pk_bf16(v0[2], v0[3]); w.z = cvt_pk_bf16(v1[0], v1[1]); w.w = cvt_pk_bf16(v1[2], v1[3]);
                    bf16_t* p;
                    if (isU) { const int b = row >> 12, t = row & 4095, g = col >> 4, h0 = col & 15; p = base + ((size_t)((b * 64 + g) * 4096 + t)) * 16 + h0; }
                    else p = base + (size_t)row * ldc + col;
                    *(u32x4*)p = w; } }
    }
};
struct EpiGlu {
    static constexpr bool PERM = true, AFTER_DRAIN = false, HAS_MID = false;
    const bf16_t* YG; const bf16_t* ZS; const float* bias; bf16_t* MG; float* rsq;
    __device__ __forceinline__ void mid(f32x4 (&acc)[2][2][4][2], const Unit&, int, int, int, int, int, PG8_LAS unsigned char*) const {}
    __device__ __forceinline__ void operator()(const f32x4 (&acc)[2][2][4][2], const Unit& u, int ui, int wr, int wc, int fr, int fq, PG8_LAS unsigned char* lds) const {
        const int row0 = u.pm * BM + wr * 64 + fr; const int col0 = u.pn * BM + wc * 32 + 8 * fq;
        f32x4 bv[2][2];
#pragma unroll
        for (int bj = 0; bj < 2; ++bj)
#pragma unroll
            for (int n = 0; n < 2; ++n) bv[bj][n] = *(const f32x4*)(bias + col0 + bj * HALF + 4 * n);
#pragma unroll
        for (int ai = 0; ai < 2; ++ai)
#pragma unroll
            for (int m = 0; m < 4; ++m) { const int row = row0 + ai * HALF + m * 16; float ss = 0.f;
#pragma unroll
                for (int bj = 0; bj < 2; ++bj) { const int col = col0 + bj * HALF;
                    const u32x4 yv = *(const u32x4*)(YG + (size_t)row * 1024 + col), zv = *(const u32x4*)(ZS + (size_t)row * 1024 + col);
                    const f32x4 g0 = acc[ai][bj][m][0] + bv[bj][0], g1 = acc[ai][bj][m][1] + bv[bj][1];
                    float o[8];
#pragma unroll
                    for (int e = 0; e < 8; ++e) { const unsigned yw = yv[e >> 1], zw = zv[e >> 1]; const float y = (e & 1) ? bf_hi(yw) : bf_lo(yw), z = (e & 1) ? bf_hi(zw) : bf_lo(zw);
                        const float gt = e < 4 ? g0[e & 3] : g1[e & 3]; o[e] = y * sigmoidf_(gt) * z * sigmoidf_(z); ss += o[e] * o[e]; }
                    u32x4 w; w.x = cvt_pk_bf16(o[0], o[1]); w.y = cvt_pk_bf16(o[2], o[3]); w.z = cvt_pk_bf16(o[4], o[5]); w.w = cvt_pk_bf16(o[6], o[7]);
                    *(u32x4*)(MG + (size_t)row * 2048 + 1024 + col) = w; }
                ss += __shfl_xor(ss, 16); ss += __shfl_xor(ss, 32);
                if (fq == 0) rsq[(size_t)row * 16 + u.pn * 4 + wc] = ss; }
    }
};
struct EpiOut {
    static constexpr bool PERM = false, AFTER_DRAIN = false, HAS_MID = true;
    const float* X; float* OUT;
    __device__ __forceinline__ void mid(f32x4 (&acc)[2][2][4][2], const Unit& u, int ui, int wr, int wc, int fr, int fq, PG8_LAS unsigned char* lds) const {
        const PG8_LAS f32x2* tab = (const PG8_LAS f32x2*)(lds + TAB_OFF) + ui * 256;
#pragma unroll
        for (int ai = 0; ai < 2; ++ai)
#pragma unroll
            for (int m = 0; m < 4; ++m) { const float ratio = tab[ai * HALF + wr * 64 + m * 16 + fr].x;
#pragma unroll
                for (int bj = 0; bj < 2; ++bj)
#pragma unroll
                    for (int n = 0; n < 2; ++n) acc[ai][bj][m][n] = acc[ai][bj][m][n] * ratio; }
    }
    __device__ __forceinline__ void operator()(const f32x4 (&acc)[2][2][4][2], const Unit& u, int ui, int wr, int wc, int fr, int fq, PG8_LAS unsigned char* lds) const {
        const PG8_LAS f32x2* tab = (const PG8_LAS f32x2*)(lds + TAB_OFF) + ui * 256;
        const int col0 = u.pn * BM + wc * 32 + 4 * fq;
#pragma unroll
        for (int ai = 0; ai < 2; ++ai)
#pragma unroll
            for (int m = 0; m < 4; ++m) { const int r = ai * HALF + wr * 64 + m * 16 + fr; const float rs = tab[r].y; const size_t off = (size_t)(u.pm * BM + r) * 2048 + col0;
#pragma unroll
                for (int bj = 0; bj < 2; ++bj)
#pragma unroll
                    for (int n = 0; n < 2; ++n) { const f32x4 xv = *(const f32x4*)(X + off + bj * HALF + n * 16); *(f32x4*)(OUT + off + bj * HALF + n * 16) = xv + acc[ai][bj][m][n] * rs; } }
    }
};

template <class Epi, class Sched, bool ALIGN_EPI = false, bool SP2 = false>
__device__ __forceinline__ void gemm_phase(PG8_LAS unsigned char* lds, const Gemm g, const Sched& S, const Epi& E) {
    const int tid = threadIdx.x, wid = __builtin_amdgcn_readfirstlane(tid >> 6), lane = tid & 63, wr = wid >> 2, wc = wid & 3, fr = lane & 15, fq = lane >> 4;
    const int K = g.K, nt = K / BK;
    unsigned voffA[2], voffB[2];
#pragma unroll
    for (int i = 0; i < 2; ++i) { int R, C; stage_rc(tid * 16 + i * 8192, R, C); const int Rb = Epi::PERM ? ((R & ~31) + perm32(R & 31)) : R;
        voffA[i] = (unsigned)(R * K + C) * 2u; voffB[i] = (unsigned)(Rb * K + C) * 2u; }
    const size_t kstep = (size_t)(BK * 2);
    const size_t hstep = (size_t)HALF * K * 2;
    const size_t tstep = 2 * hstep;
    const unsigned ldsw = (unsigned)wid * 1024u;
    const int aoff = lds_byte(wr * 64 + fr, fq * 8), boff = lds_byte(wc * 32 + fr, fq * 8);
#define PG8_SA(b, h) (((b) * 2 + (h)) * HTB)
#define PG8_SB(b, h) ((4 + (b) * 2 + (h)) * HTB)
#define PG8_STAGE(bufoff, gbase, voff) do { _Pragma("unroll") for (int _i = 0; _i < 2; ++_i) \
        __builtin_amdgcn_global_load_lds((const unsigned*)((const char*)(gbase) + (voff)[_i]), (PG8_LAS unsigned*)(lds + (bufoff) + ldsw + _i * 8192), 16, 0, 0); } while (0)
#define PG8_LDA(dst, b, h) do { _Pragma("unroll") for (int m = 0; m < 4; ++m) _Pragma("unroll") for (int k = 0; k < 2; ++k) dst[m][k] = *(const PG8_LAS bf16x8*)(lds + PG8_SA(b, h) + aoff + m * 2048 + k * 1024); } while (0)
#define PG8_LDB(dst, b, h) do { _Pragma("unroll") for (int n = 0; n < 2; ++n) _Pragma("unroll") for (int k = 0; k < 2; ++k) dst[n][k] = *(const PG8_LAS bf16x8*)(lds + PG8_SB(b, h) + boff + n * 2048 + k * 1024); } while (0)
#define PG8_MMA(ai, bj, At, Bt) do { __builtin_amdgcn_s_setprio(1); _Pragma("unroll") for (int m = 0; m < 4; ++m) _Pragma("unroll") for (int n = 0; n < 2; ++n) _Pragma("unroll") for (int k = 0; k < 2; ++k) \
        acc[ai][bj][m][n] = __builtin_amdgcn_mfma_f32_16x16x32_bf16(Bt[n][k], At[m][k], acc[ai][bj][m][n], 0, 0, 0); __builtin_amdgcn_s_setprio(0); } while (0)
#define PG8_WAIT_V(n) asm volatile("s_waitcnt vmcnt(" #n ")" ::: "memory")
#define PG8_WAIT_L(n) asm volatile("s_waitcnt lgkmcnt(" #n ")" ::: "memory")
#define PG8_BAR __builtin_amdgcn_s_barrier()
#define PG8_SCHED __builtin_amdgcn_sched_barrier(0)
    Unit cur, nxt; int ui = 0;
    if (!S.next(0, cur)) return;
    f32x4 acc[2][2][4][2];
#pragma unroll
    for (int a = 0; a < 2; ++a)
#pragma unroll
        for (int b = 0; b < 2; ++b)
#pragma unroll
            for (int m = 0; m < 4; ++m)
#pragma unroll
                for (int n = 0; n < 2; ++n) acc[a][b][m][n] = (f32x4){0.f, 0.f, 0.f, 0.f};
    bf16x8 At[4][2], B0[2][2], B1[2][2];
    const char* cA = (const char*)g.A + (size_t)cur.pm * tstep; const char* cB = (const char*)g.Bt + (size_t)cur.pn * tstep;
    S.a_ready(cur);
    if constexpr (SP2) {
        PG8_STAGE(PG8_SB(0, 0), cB, voffB); PG8_STAGE(PG8_SB(0, 1), cB + hstep, voffB); PG8_STAGE(PG8_SA(0, 0), cA, voffA); PG8_STAGE(PG8_SA(0, 1), cA + hstep, voffA);
        if (wr == 1) PG8_BAR;
        PG8_WAIT_V(2); PG8_BAR;
        PG8_STAGE(PG8_SB(1, 0), cB + kstep, voffB); PG8_STAGE(PG8_SA(1, 0), cA + kstep, voffA); PG8_STAGE(PG8_SB(1, 1), cB + hstep + kstep, voffB);
        PG8_WAIT_V(6); PG8_BAR;
    } else {
        PG8_STAGE(PG8_SB(0, 0), cB, voffB); PG8_STAGE(PG8_SA(0, 0), cA, voffA); PG8_STAGE(PG8_SB(0, 1), cB + hstep, voffB); PG8_STAGE(PG8_SA(0, 1), cA + hstep, voffA);
        if (wr == 1) PG8_BAR;
        PG8_WAIT_V(4); PG8_BAR;
        PG8_STAGE(PG8_SB(1, 0), cB + kstep, voffB); PG8_STAGE(PG8_SA(1, 0), cA + kstep, voffA); PG8_STAGE(PG8_SB(1, 1), cB + hstep + kstep, voffB);
        PG8_WAIT_V(6); PG8_BAR;
    }
    for (;;) {
        const bool has_next = S.next(ui + 1, nxt);
        const char* nA = has_next ? (const char*)g.A + (size_t)nxt.pm * tstep : cA; const char* nB = has_next ? (const char*)g.Bt + (size_t)nxt.pn * tstep : cB;
        for (int t = 0; t < nt; t += 2) {
            if constexpr (Epi::HAS_MID) { if (t == nt / 2) E.mid(acc, cur, ui, wr, wc, fr, fq, lds); }
            const bool last = (t == nt - 2);
            const char* a1 = cA + (size_t)(t + 1) * kstep;
            const char* a2 = last ? nA : cA + (size_t)(t + 2) * kstep; const char* b2 = last ? nB : cB + (size_t)(t + 2) * kstep;
            const char* a3 = a2 + kstep; const char* b3 = b2 + kstep;
            if (last && has_next) S.a_ready(nxt);
            if constexpr (SP2) {
            PG8_LDB(B0, 0, 0); PG8_LDB(B1, 0, 1); PG8_SCHED; PG8_LDA(At, 0, 0); PG8_STAGE(PG8_SA(1, 1), a1 + hstep, voffA);
            PG8_WAIT_V(8); PG8_WAIT_L(0); PG8_BAR; PG8_MMA(0, 0, At, B0); PG8_MMA(0, 1, At, B1); PG8_BAR; PG8_SCHED;
            PG8_LDA(At, 0, 1); PG8_STAGE(PG8_SB(0, 0), b2, voffB); PG8_STAGE(PG8_SB(0, 1), b2 + hstep, voffB); PG8_STAGE(PG8_SA(0, 0), a2, voffA);
            PG8_WAIT_V(8); PG8_WAIT_L(0); PG8_BAR; PG8_MMA(1, 0, At, B0); PG8_MMA(1, 1, At, B1); PG8_BAR; PG8_SCHED;
            PG8_LDB(B0, 1, 0); PG8_LDB(B1, 1, 1); PG8_SCHED; PG8_LDA(At, 1, 0); PG8_STAGE(PG8_SA(0, 1), a2 + hstep, voffA);
            PG8_WAIT_V(8); PG8_WAIT_L(0); PG8_BAR; PG8_MMA(0, 0, At, B0); PG8_MMA(0, 1, At, B1); PG8_BAR; PG8_SCHED;
            PG8_LDA(At, 1, 1); PG8_STAGE(PG8_SB(1, 0), b3, voffB); PG8_STAGE(PG8_SB(1, 1), b3 + hstep, voffB); PG8_STAGE(PG8_SA(1, 0), a3, voffA);
            PG8_WAIT_V(8); PG8_WAIT_L(0); PG8_BAR; PG8_MMA(1, 0, At, B0); PG8_MMA(1, 1, At, B1); PG8_BAR; PG8_SCHED;
            } else {
            PG8_LDB(B0, 0, 0); PG8_SCHED; PG8_LDA(At, 0, 0); PG8_STAGE(PG8_SA(1, 1), a1 + hstep, voffA);
            PG8_WAIT_L(8); PG8_BAR; PG8_WAIT_L(0); PG8_MMA(0, 0, At, B0); PG8_BAR; PG8_SCHED;
            PG8_LDB(B1, 0, 1); PG8_STAGE(PG8_SB(0, 0), b2, voffB);
            PG8_BAR; PG8_WAIT_L(0); PG8_MMA(0, 1, At, B1); PG8_BAR;
            PG8_LDA(At, 0, 1); PG8_STAGE(PG8_SA(0, 0), a2, voffA);
            PG8_BAR; PG8_WAIT_L(0); PG8_MMA(1, 0, At, B0); PG8_BAR; PG8_SCHED;
            PG8_STAGE(PG8_SB(0, 1), b2 + hstep, voffB);
            PG8_WAIT_V(6); PG8_BAR; PG8_MMA(1, 1, At, B1); PG8_BAR;
            PG8_LDB(B0, 1, 0); PG8_SCHED; PG8_LDA(At, 1, 0); PG8_STAGE(PG8_SA(0, 1), a2 + hstep, voffA);
            PG8_WAIT_L(8); PG8_BAR; PG8_WAIT_L(0); PG8_MMA(0, 0, At, B0); PG8_BAR; PG8_SCHED;
            PG8_LDB(B1, 1, 1); PG8_STAGE(PG8_SB(1, 0), b3, voffB);
            PG8_BAR; PG8_WAIT_L(0); PG8_MMA(0, 1, At, B1); PG8_BAR;
            PG8_LDA(At, 1, 1); PG8_STAGE(PG8_SA(1, 0), a3, voffA);
            PG8_BAR; PG8_WAIT_L(0); PG8_MMA(1, 0, At, B0); PG8_BAR; PG8_SCHED;
            PG8_STAGE(PG8_SB(1, 1), b3 + hstep, voffB);
            PG8_WAIT_V(6); PG8_BAR; PG8_MMA(1, 1, At, B1); PG8_BAR;
            }
        }
        if constexpr (ALIGN_EPI) { if (wr == 0) PG8_BAR; }
        E(acc, cur, ui, wr, wc, fr, fq, lds); S.done(cur);
        if (!has_next) break;
#pragma unroll
        for (int a = 0; a < 2; ++a)
#pragma unroll
            for (int b = 0; b < 2; ++b)
#pragma unroll
                for (int m = 0; m < 4; ++m)
#pragma unroll
                    for (int n = 0; n < 2; ++n) acc[a][b][m][n] = (f32x4){0.f, 0.f, 0.f, 0.f};
        cur = nxt; cA = nA; cB = nB; ++ui;
        if constexpr (ALIGN_EPI) { if (wr == 1) PG8_BAR; }
    }
    PG8_WAIT_V(0);
    if constexpr (!ALIGN_EPI) { if (wr == 0) PG8_BAR; }
    PG8_BAR;

#undef PG8_SA
#undef PG8_SB
#undef PG8_STAGE
#undef PG8_LDA
#undef PG8_LDB
#undef PG8_MMA
#undef PG8_WAIT_V
#undef PG8_WAIT_L
#undef PG8_BAR
#undef PG8_SCHED
}
}
constexpr int NWAVES = 8;
#ifndef MK_N_LAUNCHES
#define MK_N_LAUNCHES 1
#endif
constexpr int N_LAUNCHES = MK_N_LAUNCHES;
constexpr int PER_PHASE = 5;

constexpr size_t MiB = 1u << 20;
constexpr size_t WS_CTL = 0, CTL_ZERO_BYTES = 1 * MiB;
constexpr size_t WS_WIN = 2 * MiB, WS_WGLU = 20 * MiB, WS_WOUT = 22 * MiB;
constexpr size_t WS_ROPE = 30 * MiB;
constexpr size_t WS_RSQA = 34 * MiB, WS_RSQS = 35 * MiB;
constexpr size_t WS_SSMT = 36 * MiB, SSM_GSTRIDE = 327680;
constexpr size_t SSM_OFF_T = 0, SSM_OFF_WIN = 36864, SSM_OFF_WOUT = 167936, SSM_OFF_W32 = 299008;
constexpr size_t WS_XN = 64 * MiB;
constexpr size_t WS_Q = 128 * MiB, WS_K = 160 * MiB, WS_V = 168 * MiB, WS_ZA = 176 * MiB, WS_U = 208 * MiB, WS_ZS = 240 * MiB;
constexpr size_t WS_YG = 272 * MiB, WS_MG = 304 * MiB, WS_END = 368 * MiB;
static_assert(WS_SSMT + 64 * SSM_GSTRIDE <= WS_XN, "d_ws map");
constexpr int CW_TMO = 0, CW_CODE = 1, CW_BAR = 4096;

constexpr int RING_OFF = 0, RING_BYTES = 131072;
constexpr int LDSCTL_OFF = RING_BYTES, MISC_OFF = LDSCTL_OFF + 320;
constexpr int LDS_BYTES = 147456;

#define GAS __attribute__((address_space(1)))
#define LAS __attribute__((address_space(3)))
typedef unsigned short bf16;
typedef unsigned v4u __attribute__((ext_vector_type(4)));
typedef float f32x4 __attribute__((ext_vector_type(4)));
typedef short bf16x8 __attribute__((ext_vector_type(8)));
typedef GAS unsigned gu32;
typedef GAS unsigned long long gu64;
#define RLX_AGENT __ATOMIC_RELAXED, __HIP_MEMORY_SCOPE_AGENT
#define LDS_WAIT() asm volatile("s_waitcnt lgkmcnt(0)" ::: "memory")
#define VM_WAIT() asm volatile("s_waitcnt vmcnt(0)" ::: "memory")
__device__ __forceinline__ unsigned long long rt() { return __builtin_amdgcn_s_memrealtime(); }
__device__ __forceinline__ unsigned f2bf(float f) { unsigned u = __builtin_bit_cast(unsigned, f); return (u + 0x7fffu + ((u >> 16) & 1u)) >> 16; }
__device__ __forceinline__ unsigned pk2(float lo, float hi) { return f2bf(lo) | (f2bf(hi) << 16); }

#define XB_TMO      128
#define XB_XCNT(j)  (256  + 64 * (j))
#define XB_XSUB(j)  (1280 + 64 * (j))
#define XB_XGEN(j)  (2304 + 64 * (j))
#define XB_TOP      3328
#define XB_TOPGEN   3392
#define XCD_BAR_WORDS 3456
#define XB_SPIN_CAP (1u << 18)

__device__ __forceinline__ unsigned xb_ld(unsigned* p)              { return __hip_atomic_load(p, __ATOMIC_RELAXED, __HIP_MEMORY_SCOPE_AGENT); }
__device__ __forceinline__ unsigned xb_add(unsigned* p, unsigned v) { return __hip_atomic_fetch_add(p, v, __ATOMIC_RELAXED, __HIP_MEMORY_SCOPE_AGENT); }
__device__ __forceinline__ unsigned xb_xcc_id() { return (unsigned)__builtin_amdgcn_s_getreg((3 << 11) | 20) & 0xFu; }
#define XB_SPIN(cond, bar) do { unsigned _sp = 0; while (cond) { __builtin_amdgcn_s_sleep(1); \
    if ((++_sp & 255u) == 0u) { if (xb_ld(&(bar)[XB_TMO])) break; if (_sp > XB_SPIN_CAP) { atomicAdd(&(bar)[XB_TMO], 1u); break; } } } } while (0)

struct XcdBarrier {
    unsigned* bar; unsigned x;
    volatile LAS unsigned* st;
};

__device__ __forceinline__ XcdBarrier xcd_barrier_post(unsigned* bar, volatile LAS unsigned* st) {
    XcdBarrier b; b.bar = bar; b.x = xb_xcc_id(); b.st = st;
    if (threadIdx.x == 0) (void)xb_add(&bar[XB_XCNT(b.x)], 1u);
    return b;
}
__device__ __forceinline__ void xcd_barrier_complete(unsigned* bar, unsigned x, unsigned& nloc, unsigned& nx) {
    const unsigned G = gridDim.x * gridDim.y * gridDim.z;
    unsigned sum, cnt, mine, sp = 0u;
    for (;;) {
        sum = 0u; cnt = 0u; mine = 0u;
#pragma unroll
        for (unsigned j = 0; j < 16; ++j) { const unsigned c = xb_ld(&bar[XB_XCNT(j)]); sum += c; cnt += (c > 0u) ? 1u : 0u; mine = (j == x) ? c : mine; }
        if (sum == G) break;
        __builtin_amdgcn_s_sleep(1);
        if ((++sp & 255u) == 0u) { if (xb_ld(&bar[XB_TMO])) break; if (sp > XB_SPIN_CAP) { atomicAdd(&bar[XB_TMO], 1u); break; } }
    }
    nloc = mine > 0u ? mine : 1u; nx = cnt > 0u ? cnt : 1u;
}

__device__ __forceinline__ void xcd_barrier(const XcdBarrier& b) {
    asm volatile("s_waitcnt vmcnt(0)" ::: "memory");
    __syncthreads();
    if (threadIdx.x == 0) {
        unsigned* bar = b.bar;
        __builtin_amdgcn_s_waitcnt(0);
        unsigned nloc = b.st[0], nx = b.st[1];
        if (nloc == 0u) { xcd_barrier_complete(bar, b.x, nloc, nx); b.st[0] = nloc; b.st[1] = nx; }
        const unsigned old = xb_add(&bar[XB_XSUB(b.x)], 1u);
        const unsigned gen = old / nloc;
        if (old + 1u == (gen + 1u) * nloc) {
            __builtin_amdgcn_fence(__ATOMIC_RELEASE, "agent");
            asm volatile("s_waitcnt vmcnt(0)" ::: "memory");
            const unsigned og = xb_add(&bar[XB_TOP], 1u);
            const unsigned tg = og / nx;
            if (og + 1u == (tg + 1u) * nx) xb_add(&bar[XB_TOPGEN], 1u);
            else XB_SPIN(xb_ld(&bar[XB_TOPGEN]) == tg, bar);
            __builtin_amdgcn_fence(__ATOMIC_ACQUIRE, "agent");
            xb_add(&bar[XB_XGEN(b.x)], 1u);
            asm volatile("s_waitcnt vmcnt(0)" ::: "memory");
        } else {
            XB_SPIN(xb_ld(&bar[XB_XGEN(b.x)]) == gen, bar);
            __builtin_amdgcn_fence(__ATOMIC_ACQUIRE, "agent");
            asm volatile("s_waitcnt vmcnt(0)" ::: "memory");
        }
    }
    __syncthreads();
}
struct Frame {
    LAS unsigned char* lds; volatile LAS unsigned* MISC; gu32* ctl;
    int tid, lane, wave, vcu, G;
    const float *x, *norm_w, *w_in, *q_norm_w, *k_norm_w, *sinks, *a_re, *a_im, *log_step, *b_re, *b_im, *c_re, *c_im, *d_skip, *w_glu, *b_glu, *anw, *snw, *w_out;
    const int* positions; float* out;
    bf16 *Win_t, *Wglu_t, *Wout_t, *XN, *Q, *KB, *VB, *ZA, *U, *ZS, *YG, *MG;
    float *cos_t, *sin_t, *rsq_a, *rsq_s; unsigned char* ssmt;
};
__device__ __forceinline__ float wave_sum(float v) {
#pragma unroll
    for (int o = 1; o < 64; o <<= 1) v += __shfl_xor(v, o);
    return v;
}
__device__ __forceinline__ float wave_max(float v) {
#pragma unroll
    for (int o = 1; o < 64; o <<= 1) v = fmaxf(v, __shfl_xor(v, o));
    return v;
}
__device__ __forceinline__ float bf2f(bf16 v) { return __uint_as_float((unsigned)v << 16); }
__device__ __forceinline__ double exp_d(double x) {
    const double k = rint(x * 1.4426950408889634); const double r = (x - k * 6.93147180369123816490e-01) - k * 1.90821492927058770002e-10;
    double p = 1.0 / 6227020800.0;
    p = p * r + 1.0 / 479001600.0; p = p * r + 1.0 / 39916800.0; p = p * r + 1.0 / 3628800.0; p = p * r + 1.0 / 362880.0; p = p * r + 1.0 / 40320.0; p = p * r + 1.0 / 5040.0;
    p = p * r + 1.0 / 720.0; p = p * r + 1.0 / 120.0; p = p * r + 1.0 / 24.0; p = p * r + 1.0 / 6.0; p = p * r + 0.5; p = p * r + 1.0; p = p * r + 1.0;
    return __builtin_ldexp(p, (int)k);
}
__device__ __forceinline__ void sincos_d(double x, double& c, double& s) {
    const double k = rint(x * 0.63661977236758134308); const double r = (x - k * 1.57079632673412561417e+00) - k * 6.07710050650619224932e-11; const double r2 = r * r;
    double ps = -1.0 / 6227020800.0; ps = ps * r2 + 1.0 / 39916800.0; ps = ps * r2 - 1.0 / 362880.0; ps = ps * r2 + 1.0 / 5040.0; ps = ps * r2 - 1.0 / 120.0; ps = ps * r2 + 1.0 / 6.0; ps = r - r * r2 * ps;
    double pc = 1.0 / 87178291200.0; pc = pc * r2 - 1.0 / 479001600.0; pc = pc * r2 + 1.0 / 3628800.0; pc = pc * r2 - 1.0 / 40320.0; pc = pc * r2 + 1.0 / 720.0; pc = pc * r2 - 1.0 / 24.0; pc = pc * r2 + 0.5; pc = 1.0 - r2 * pc;
    const int q = (int)((long long)k & 3);
    c = (q == 0) ? pc : (q == 1) ? -ps : (q == 2) ? -pc : ps;
    s = (q == 0) ? ps : (q == 1) ? pc : (q == 2) ? -ps : -pc;
}
__device__ __forceinline__ float inv_freq_f(int f) { return (float)exp_d(-(double)f * (9.210340371976184 / 32.0)); }

__device__ __forceinline__ void p0_transpose_item(const float* W, int K, int N, bf16* WT, const float* kscale, LAS float* scr, int item, int lane) {
    const int nblk = N / 32, kb = item / nblk, nb = item % nblk, k0 = 64 * kb, n0 = 32 * nb;
#pragma unroll 8
    for (int i = 0; i < 32; ++i) { const int kk = 2 * i + (lane >> 5); float v = W[(size_t)(k0 + kk) * N + n0 + (lane & 31)]; if (kscale) v *= kscale[k0 + kk]; scr[kk * 33 + (lane & 31)] = v; }
    LDS_WAIT(); asm volatile("" ::: "memory");
    const int c = lane & 7;
#pragma unroll
    for (int j = 0; j < 4; ++j) { const int n = (lane >> 3) + 8 * j; const LAS float* s = scr + (8 * c) * 33 + n;
        v4u o; o.x = pk2(s[0 * 33], s[1 * 33]); o.y = pk2(s[2 * 33], s[3 * 33]); o.z = pk2(s[4 * 33], s[5 * 33]); o.w = pk2(s[6 * 33], s[7 * 33]);
        *(GAS v4u*)(WT + (size_t)(n0 + n) * K + k0 + 8 * c) = o; }
    LDS_WAIT(); asm volatile("" ::: "memory");
}
__device__ __forceinline__ void rms_row_to_bf16(const float* xrow, const float* nw, bf16* orow, int lane) {
    const GAS f32x4* xr = (const GAS f32x4*)xrow + lane; const GAS f32x4* wr = (const GAS f32x4*)nw + lane;
    f32x4 v[8]; float s = 0.f;
#pragma unroll
    for (int j = 0; j < 8; ++j) { v[j] = xr[64 * j]; s += (v[j].x * v[j].x + v[j].y * v[j].y) + (v[j].z * v[j].z + v[j].w * v[j].w); }
    const float rstd = 1.0f / sqrtf(wave_sum(s) * (1.f / DM) + EPS);
    GAS unsigned long long* o8 = (GAS unsigned long long*)orow + lane;
#pragma unroll
    for (int j = 0; j < 8; ++j) { const f32x4 w = wr[64 * j]; const f32x4 o = v[j] * rstd * w; o8[64 * j] = (unsigned long long)pk2(o.x, o.y) | ((unsigned long long)pk2(o.z, o.w) << 32); }
}
__device__ __forceinline__ void p0_ssm_tables(Frame& F, int g, int q) {
    typedef float f2 __attribute__((ext_vector_type(2)));
    LAS f2* pw = (LAS f2*)(F.lds + RING_OFF);
    LAS f2* bb = (LAS f2*)(F.lds + RING_OFF + 17408);
    LAS f2* cc = (LAS f2*)(F.lds + RING_OFF + 25600);
    const int tid = F.tid;
    __syncthreads();
    if (tid < 64) { const int p = tid;
        const double dl = exp_d((double)F.log_step[g]); const double ar = (double)F.a_re[g * 64 + p], ai = (double)F.a_im[g * 64 + p];
        const double mag = exp_d(ar * dl); double c, s; sincos_d(ai * dl, c, s); const double wr = mag * c, wi = mag * s;
        const double nr = wr - 1.0, ni = wi, den = ar * ar + ai * ai; const double cr = (nr * ar + ni * ai) / den, ci = (ni * ar - nr * ai) / den;
#pragma unroll
        for (int h = 0; h < 16; ++h) { const double br = (double)F.b_re[(g * 64 + p) * 16 + h], bi = (double)F.b_im[(g * 64 + p) * 16 + h]; bb[p * 16 + h] = (f2){(float)(cr * br - ci * bi), (float)(cr * bi + ci * br)}; }
        double pr = 1.0, pi = 0.0;
        for (int e = 0; e <= 32; ++e) { pw[e * 64 + p] = (f2){(float)pr, (float)pi}; const double n2 = pr * wr - pi * wi; pi = pr * wi + pi * wr; pr = n2; }
    }
    for (int i = tid; i < 1024; i += NWAVES * 64) cc[i] = (f2){F.c_re[g * 1024 + i], F.c_im[g * 1024 + i]};
    __syncthreads();
    unsigned char* base = F.ssmt + (size_t)g * SSM_GSTRIDE;
    if (q == 0) {
        for (int x = tid; x < 2048; x += NWAVES * 64) { const int dd = x >> 6, ln = x & 63, r32 = ln & 31, hi = ln >> 5, jj = r32 >> 4, h = r32 & 15, d = dd - 1 + jj;
            float v[8];
#pragma unroll
            for (int e = 0; e < 8; ++e) v[e] = 0.f;
            if (d >= 0 && d <= 31) {
                for (int p = 0; p < 64; ++p) { const f2 c = cc[h * 64 + p], w = pw[d * 64 + p]; const float mr = c.x * w.x - c.y * w.y, mi = c.x * w.y + c.y * w.x;
#pragma unroll
                    for (int e = 0; e < 8; ++e) { const f2 b = bb[p * 16 + 8 * hi + e]; v[e] += mr * b.x - mi * b.y; } }
                if (d == 0) {
#pragma unroll
                    for (int e = 0; e < 8; ++e) if (8 * hi + e == h) v[e] += F.d_skip[g * 16 + h]; }
            }
            v4u o; o.x = pk2(v[0], v[1]); o.y = pk2(v[2], v[3]); o.z = pk2(v[4], v[5]); o.w = pk2(v[6], v[7]);
            *(GAS v4u*)(base + SSM_OFF_T + (size_t)(dd * 64 + ln) * 16) = o; }
    } else if (q == 1) {
        for (int x = tid; x < 8192; x += NWAVES * 64) { const int ln = x & 63, i = (x >> 6) & 31, pt = x >> 11, r32 = ln & 31, hi = ln >> 5, pc = 32 * pt + r32, p = pc & 63, im = pc >> 6;
            const f2 w = pw[(31 - i) * 64 + p]; float v[8];
#pragma unroll
            for (int e = 0; e < 8; ++e) { const f2 b = bb[p * 16 + 8 * hi + e]; v[e] = im ? (w.x * b.y + w.y * b.x) : (w.x * b.x - w.y * b.y); }
            v4u o; o.x = pk2(v[0], v[1]); o.y = pk2(v[2], v[3]); o.z = pk2(v[4], v[5]); o.w = pk2(v[6], v[7]);
            *(GAS v4u*)(base + SSM_OFF_WIN + (size_t)((pt * 32 + i) * 64 + ln) * 16) = o; }
    } else if (q == 2) {
        for (int x = tid; x < 8192; x += NWAVES * 64) { const int ln = x & 63, ks = (x >> 6) & 7, rt = x >> 9, r32 = ln & 31, hi = ln >> 5, jj = r32 >> 4, h = r32 & 15, j = 2 * rt + jj;
            float v[8];
#pragma unroll
            for (int e = 0; e < 8; ++e) { const int pc = 16 * ks + 8 * hi + e, p = pc & 63, im = pc >> 6; const f2 c = cc[h * 64 + p], w = pw[(j + 1) * 64 + p];
                const float mr = c.x * w.x - c.y * w.y, mi = c.x * w.y + c.y * w.x; v[e] = im ? -mi : mr; }
            v4u o; o.x = pk2(v[0], v[1]); o.y = pk2(v[2], v[3]); o.z = pk2(v[4], v[5]); o.w = pk2(v[6], v[7]);
            *(GAS v4u*)(base + SSM_OFF_WOUT + (size_t)((rt * 8 + ks) * 64 + ln) * 16) = o; }
    } else {
        if (tid < 64) *(GAS f2*)(base + SSM_OFF_W32 + tid * 8) = pw[32 * 64 + tid];
    }
}
__device__ __forceinline__ void p0_prologue(Frame& F) {
    for (int it = blockIdx.x; it < 256; it += F.G) p0_ssm_tables(F, it >> 2, it & 3);
    __syncthreads();
    LAS float* scr = (LAS float*)(F.lds + RING_OFF + F.wave * 16384);
    const int gw = F.vcu * NWAVES + F.wave, NGW = F.G * NWAVES;
    constexpr int I_IN = (DM / 64) * (INW / 32), I_GLU = (SW / 64) * (SW / 32), I_OUT = (DM / 64) * (DM / 32);
    for (int it = gw; it < I_IN + I_GLU + I_OUT; it += NGW) {
        int r = it;
        if (r < I_IN) { p0_transpose_item(F.w_in, DM, INW, F.Win_t, nullptr, scr, r, F.lane); continue; } r -= I_IN;
        if (r < I_GLU) { p0_transpose_item(F.w_glu, SW, SW, F.Wglu_t, nullptr, scr, r, F.lane); continue; } r -= I_GLU;
        { const int kb = r / (DM / 32); const float* gain = (kb < 16) ? F.anw : (F.snw - 1024); p0_transpose_item(F.w_out, DM, DM, F.Wout_t, gain, scr, r, F.lane); }
    }
    for (int m = gw; m < M; m += NGW) rms_row_to_bf16(F.x + (size_t)m * DM, F.norm_w, F.XN + (size_t)m * DM, F.lane);
    { const int gt = F.vcu * (NWAVES * 64) + F.tid, NT = F.G * NWAVES * 64;
      for (int i = gt; i < M * 32; i += NT) { const int m = i >> 5, f = i & 31; const float ang = (float)F.positions[m] * inv_freq_f(f); double c, s; sincos_d((double)ang, c, s); F.cos_t[i] = (float)c; F.sin_t[i] = (float)s; } }
}
__device__ __forceinline__ float gelu_tanh(float y) { const float a = 0.7978845608028654f * (y + 0.044715f * y * y * y); return 0.5f * y * (2.0f - 2.0f * __builtin_amdgcn_rcpf(1.0f + __expf(2.0f * a))); }
__device__ __forceinline__ void naive_attn_item(Frame& F, int m, int head) {
    const int lane = F.lane, kvh = head >> 2, t = m & (SEQ - 1), f = lane & 31;
    const float qw = F.q_norm_w[lane], kw = F.k_norm_w[lane];
    float x = bf2f(F.Q[(size_t)m * AW + head * HD + lane]);
    float xn = x * (1.0f / sqrtf(wave_sum(x * x) * (1.f / HD) + EPS)) * qw; float pr = __shfl_xor(xn, 32);
    { const float c = F.cos_t[m * 32 + f], s = F.sin_t[m * 32 + f]; xn = (lane < 32) ? xn * c - pr * s : xn * c + pr * s; }
    const float qv = xn * 0.125f;
    float s0 = -1e30f, s1 = -1e30f;
    for (int kk = 0; kk < 128; ++kk) { if (t - 127 + kk < 0) continue; const int mk = m - 127 + kk;
        float kx = bf2f(F.KB[(size_t)mk * KVW + kvh * HD + lane]);
        float kn = kx * (1.0f / sqrtf(wave_sum(kx * kx) * (1.f / HD) + EPS)) * kw; const float pk = __shfl_xor(kn, 32);
        const float c = F.cos_t[mk * 32 + f], s = F.sin_t[mk * 32 + f]; kn = (lane < 32) ? kn * c - pk * s : kn * c + pk * s;
        const float dot = wave_sum(qv * kn);
        if ((kk & 63) == lane) { if (kk < 64) s0 = dot; else s1 = dot; } }
    const float snk = F.sinks[head]; const float mx = fmaxf(wave_max(fmaxf(s0, s1)), snk);
    const float p0 = (s0 > -1e29f) ? __expf(s0 - mx) : 0.f, p1 = (s1 > -1e29f) ? __expf(s1 - mx) : 0.f;
    const float den = wave_sum(p0 + p1) + __expf(snk - mx);
    float acc = 0.f;
    for (int kk = 0; kk < 128; ++kk) { if (t - 127 + kk < 0) continue; const int mk = m - 127 + kk;
        const float pkk = __shfl(kk < 64 ? p0 : p1, kk & 63); acc += pkk * bf2f(F.VB[(size_t)mk * KVW + kvh * HD + lane]); }
    float o = acc / den; const float z = bf2f(F.ZA[(size_t)m * AW + head * HD + lane]); o *= z * pg8::sigmoidf_(z);
    F.MG[(size_t)m * 2048 + head * HD + lane] = (bf16)f2bf(o);
    const float ssq = wave_sum(o * o); if (lane == 0) F.rsq_a[(size_t)m * 16 + head] = ssq;
}
__device__ __forceinline__ void naive_ssm_item(Frame& F, int b, int g) {
    const int p = F.lane;
    const double dl = exp_d((double)F.log_step[g]); const double ar = (double)F.a_re[g * 64 + p], ai = (double)F.a_im[g * 64 + p];
    const double mag = exp_d(ar * dl); double c_, s_; sincos_d(ai * dl, c_, s_); const double wrd = mag * c_, wid = mag * s_;
    const double nr = wrd - 1.0, ni = wid, den = ar * ar + ai * ai; const double cr = (nr * ar + ni * ai) / den, ci = (ni * ar - nr * ai) / den;
    const float wr = (float)wrd, wi = (float)wid;
    float bbr[16], bbi[16], ccr[16], cci[16];
#pragma unroll
    for (int h = 0; h < 16; ++h) { const double br = (double)F.b_re[(g * 64 + p) * 16 + h], bi = (double)F.b_im[(g * 64 + p) * 16 + h]; bbr[h] = (float)(cr * br - ci * bi); bbi[h] = (float)(cr * bi + ci * br);
        ccr[h] = F.c_re[(g * 16 + h) * 64 + p]; cci[h] = F.c_im[(g * 16 + h) * 64 + p]; }
    const float dsk = (p < 16) ? F.d_skip[g * 16 + p] : 0.f;
    float hr = 0.f, hi = 0.f;
    const bf16* up = F.U + (size_t)((b * 64 + g) * 4096) * 16;
    for (int t = 0; t < SEQ; ++t) {
        const v4u u0 = *(const GAS v4u*)(up + (size_t)t * 16), u1 = *(const GAS v4u*)(up + (size_t)t * 16 + 8);
        float u[16];
#pragma unroll
        for (int e = 0; e < 4; ++e) { u[2 * e] = pg8::bf_lo(u0[e]); u[2 * e + 1] = pg8::bf_hi(u0[e]); u[8 + 2 * e] = pg8::bf_lo(u1[e]); u[8 + 2 * e + 1] = pg8::bf_hi(u1[e]); }
        float bur = 0.f, bui = 0.f;
#pragma unroll
        for (int h = 0; h < 16; ++h) { bur += bbr[h] * u[h]; bui += bbi[h] * u[h]; }
        const float nh = wr * hr - wi * hi + bur; hi = wr * hi + wi * hr + bui; hr = nh;
        float ym = 0.f;
#pragma unroll
        for (int h = 0; h < 16; ++h) { const float y = wave_sum(ccr[h] * hr - cci[h] * hi); if (p == h) ym = y + dsk * u[h]; }
        if (p < 16) F.YG[(size_t)(b * SEQ + t) * SW + g * 16 + p] = (bf16)f2bf(gelu_tanh(ym));
    }
}
__device__ __forceinline__ void p2_naive(Frame& F) {
    const int gw = F.vcu * NWAVES + F.wave, NGW = F.G * NWAVES;
    for (int it = gw; it < BATCH * SG; it += NGW) naive_ssm_item(F, it >> 6, it & 63);
    for (int it = gw; it < M * NH; it += NGW) naive_attn_item(F, it >> 4, it & 15);
}

struct Args { const void* in[20]; float* out; unsigned char* ws; int ph_lo, ph_hi, li, pad; };
__global__ void __launch_bounds__(NWAVES * 64, 2) hymba_fwd(Args args) {
    extern __shared__ __attribute__((aligned(16))) unsigned char lds[];
    Frame F;
    F.lds = (LAS unsigned char*)lds; F.MISC = (volatile LAS unsigned*)(F.lds + MISC_OFF);
    F.tid = threadIdx.x; F.lane = F.tid & 63; F.wave = __builtin_amdgcn_readfirstlane(F.tid >> 6);
    F.G = gridDim.x; { const int bx = blockIdx.x; F.vcu = (F.G % 8 == 0) ? (bx % 8) * (F.G / 8) + bx / 8 : bx; }
    unsigned char* ws = args.ws; F.ctl = (gu32*)(ws + WS_CTL);
    F.x = (const float*)args.in[0]; F.positions = (const int*)args.in[1]; F.norm_w = (const float*)args.in[2]; F.w_in = (const float*)args.in[3];
    F.q_norm_w = (const float*)args.in[4]; F.k_norm_w = (const float*)args.in[5]; F.sinks = (const float*)args.in[6];
    F.a_re = (const float*)args.in[7]; F.a_im = (const float*)args.in[8]; F.log_step = (const float*)args.in[9];
    F.b_re = (const float*)args.in[10]; F.b_im = (const float*)args.in[11]; F.c_re = (const float*)args.in[12]; F.c_im = (const float*)args.in[13];
    F.d_skip = (const float*)args.in[14]; F.w_glu = (const float*)args.in[15]; F.b_glu = (const float*)args.in[16];
    F.anw = (const float*)args.in[17]; F.snw = (const float*)args.in[18]; F.w_out = (const float*)args.in[19]; F.out = args.out;
    F.Win_t = (bf16*)(ws + WS_WIN); F.Wglu_t = (bf16*)(ws + WS_WGLU); F.Wout_t = (bf16*)(ws + WS_WOUT); F.XN = (bf16*)(ws + WS_XN);
    F.Q = (bf16*)(ws + WS_Q); F.KB = (bf16*)(ws + WS_K); F.VB = (bf16*)(ws + WS_V); F.ZA = (bf16*)(ws + WS_ZA); F.U = (bf16*)(ws + WS_U); F.ZS = (bf16*)(ws + WS_ZS);
    F.YG = (bf16*)(ws + WS_YG); F.MG = (bf16*)(ws + WS_MG);
    F.cos_t = (float*)(ws + WS_ROPE); F.sin_t = (float*)(ws + WS_ROPE + 2 * MiB); F.rsq_a = (float*)(ws + WS_RSQA); F.rsq_s = (float*)(ws + WS_RSQS); F.ssmt = ws + WS_SSMT;
    for (int u = F.tid; u < (LDS_BYTES - LDSCTL_OFF) / 4; u += NWAVES * 64) ((LAS unsigned*)(F.lds + LDSCTL_OFF))[u] = 0u;
    __syncthreads();
    XcdBarrier bar; bar.bar = (unsigned*)(F.ctl + CW_BAR); bar.x = 0; bar.st = nullptr;
    if (N_LAUNCHES != PER_PHASE) bar = xcd_barrier_post((unsigned*)(F.ctl + CW_BAR), F.MISC + 8);
#define GRID_BAR(seam) do { if (N_LAUNCHES == PER_PHASE) { if (F.tid == 0) __hip_atomic_store(F.ctl + CW_TMO, 0xBADBA0u | (unsigned)(seam), RLX_AGENT); } else { xcd_barrier(bar); } } while (0)
    const int lo = args.ph_lo, hi = args.ph_hi;
#define IN(k) (lo <= (k) && (k) < hi)
#define BOTH(k) (IN(k) && IN((k) + 1))

    if (IN(0)) { p0_prologue(F); if (BOTH(0)) GRID_BAR(0); }
    if (IN(1)) {
        pg8::Gemm g{F.XN, F.Win_t, M, INW, DM}; pg8::StaticOrder S; S.init(M, INW, F.G, (int)blockIdx.x);
        pg8::EpiProj E{F.Q, F.KB, F.VB, F.ZA, F.U, F.ZS};
        pg8::gemm_phase<pg8::EpiProj, pg8::StaticOrder, true, true>(F.lds + RING_OFF, g, S, E);
        if (BOTH(1)) GRID_BAR(1);
    }
    if (IN(2)) { p2_naive(F); if (BOTH(2)) GRID_BAR(2); }
    if (IN(3)) {
        pg8::Gemm g{F.YG, F.Wglu_t, M, SW, SW}; pg8::StaticOrder S; S.init(M, SW, F.G, (int)blockIdx.x);
        pg8::EpiGlu E{F.YG, F.ZS, F.b_glu, F.MG, F.rsq_s};
        pg8::gemm_phase<pg8::EpiGlu, pg8::StaticOrder, true, true>(F.lds + RING_OFF, g, S, E);
        if (BOTH(3)) GRID_BAR(3);
    }
    if (IN(4)) {
        pg8::Gemm g{F.MG, F.Wout_t, M, DM, DM}; pg8::StaticOrder S; S.init(M, DM, F.G, (int)blockIdx.x);
        { typedef float f2 __attribute__((ext_vector_type(2))); LAS f2* tab = (LAS f2*)(F.lds + RING_OFF + TAB_OFF);
          for (int x = F.tid; x < 512; x += NWAVES * 64) { const int ui = x >> 8, r = x & 255; pg8::Unit u;
              if (S.next(ui, u)) { const int row = u.pm * 256 + r; const GAS f32x4* pa = (const GAS f32x4*)(F.rsq_a + (size_t)row * 16); const GAS f32x4* ps = (const GAS f32x4*)(F.rsq_s + (size_t)row * 16);
                  float sa = 0.f, ss = 0.f;
#pragma unroll
                  for (int j = 0; j < 4; ++j) { const f32x4 a = pa[j], s = ps[j]; sa += (a.x + a.y) + (a.z + a.w); ss += (s.x + s.y) + (s.z + s.w); }
                  const float ra = 1.0f / sqrtf(sa * (1.f / AW) + EPS), rs = 1.0f / sqrtf(ss * (1.f / SW) + EPS);
                  tab[x] = (f2){ra / rs, rs}; } }
          __syncthreads(); }
        pg8::EpiOut E{F.x, F.out};
        pg8::gemm_phase<pg8::EpiOut, pg8::StaticOrder, true, true>(F.lds + RING_OFF, g, S, E);
    }
#undef IN
#undef BOTH
}

extern "C" void kernel_launch(void* const* d_in, const int* in_sizes, int n_in, void* d_out, int out_size, void* d_ws, size_t ws_size, hipStream_t stream) {
    static int grid = 0;
    if (grid == 0) {
        if (n_in != 20 || in_sizes[0] != M * DM || out_size != M * DM || ws_size < WS_END) { fprintf(stderr, "kernel_launch: unexpected shapes (n_in %d, in0 %d, out %d, ws %zu); nothing launched\n", n_in, n_in > 0 ? in_sizes[0] : -1, out_size, ws_size); grid = -1; return; }
        int dev = 0, cus = 0, per_cu = 0;
        if (hipGetDevice(&dev) != hipSuccess || hipDeviceGetAttribute(&cus, hipDeviceAttributeMultiprocessorCount, dev) != hipSuccess) { grid = -1; return; }
        if (hipFuncSetAttribute((const void*)hymba_fwd, hipFuncAttributeMaxDynamicSharedMemorySize, LDS_BYTES) != hipSuccess) { fprintf(stderr, "kernel_launch: hipFuncSetAttribute failed\n"); grid = -1; return; }
        if (hipOccupancyMaxActiveBlocksPerMultiprocessor(&per_cu, (const void*)hymba_fwd, NWAVES * 64, LDS_BYTES) != hipSuccess || per_cu < 1) fprintf(stderr, "kernel_launch: occupancy query reports %d workgroups per CU\n", per_cu);
        (void)hipGetLastError();
        grid = cus;
    }
    if (grid < 0) return;
    if (hipMemsetAsync((char*)d_ws + WS_CTL, 0, CTL_ZERO_BYTES, stream) != hipSuccess) { fprintf(stderr, "kernel_launch: hipMemsetAsync failed\n"); return; }
    Args a{};
    for (int i = 0; i < 20; ++i) a.in[i] = d_in[i];
    a.out = (float*)d_out; a.ws = (unsigned char*)d_ws;
    for (int li = 0; li < N_LAUNCHES; ++li) {
        a.ph_lo = (N_LAUNCHES == PER_PHASE) ? li : 0; a.ph_hi = (N_LAUNCHES == PER_PHASE) ? li + 1 : PER_PHASE; a.li = li;
        hipLaunchKernelGGL(hymba_fwd, dim3(grid), dim3(NWAVES * 64), LDS_BYTES, stream, a);
        const hipError_t le = hipPeekAtLastError();
        if (le != hipSuccess) { fprintf(stderr, "kernel_launch: launch %d failed: %s\n", li, hipGetErrorName(le)); break; }
    }
}
```

```cpp
#include <hip/hip_runtime.h>
#include <cstdio>
#include <cstdint>

#ifndef WGM_P1
#define WGM_P1 3
#endif
#ifndef WGM_P3
#define WGM_P3 4
#endif
#ifndef WGM_P4
#define WGM_P4 4
#endif
#ifndef P4_SKEW_US
#define P4_SKEW_US 0
#endif
#ifndef PROBE_PAD_PHASE
#define PROBE_PAD_PHASE -1
#endif
#ifndef PROBE_PAD_US
#define PROBE_PAD_US 0
#endif
#define PAD_BEGIN(k) const unsigned long long pad_t0_##k = (PROBE_PAD_PHASE == (k)) ? __builtin_amdgcn_s_memrealtime() : 0ull
#define PAD_END(k) do { if (PROBE_PAD_PHASE == (k)) { while (__builtin_amdgcn_s_memrealtime() - pad_t0_##k < (unsigned long long)(PROBE_PAD_US) * 100ull) __builtin_amdgcn_s_sleep(8); } } while (0)
#ifndef PROBE_DUP
#define PROBE_DUP -1
#endif
#define REPS(k) _Pragma("unroll") for (int rep_ = 0; rep_ < ((PROBE_DUP == (k)) ? 2 : 1); ++rep_)
constexpr int BATCH = 4, SEQ = 4096, DM = 2048, M = BATCH * SEQ;
constexpr int AW = 1024, KVW = 256, SW = 1024, INW = 4608, HD = 64, NH = 16, NKV = 4;
constexpr int SG = 64, SH = 16, SP = 64;
constexpr float EPS = 1e-6f;
constexpr int XP_OFF = 142848, TAB_OFF = 159232;

namespace pg8 {
#define PG8_LAS __attribute__((address_space(3)))
typedef unsigned short bf16_t;
typedef short bf16x8 __attribute__((ext_vector_type(8)));
typedef float f32x4 __attribute__((ext_vector_type(4)));
typedef unsigned u32x4 __attribute__((ext_vector_type(4)));
constexpr int BM = 256, BK = 64, HALF = 128, HTB = HALF * BK * 2  , STAGE_BYTES = 8 * HTB, NXCD = 8, WGM = 8;

__host__ __device__ __forceinline__ int lds_byte(int r, int c) { const int st = (r >> 4) * 2 + (c >> 5), rr = r & 15, cc = c & 31, ob = rr * 64 + cc * 2; return st * 1024 + (ob ^ (((ob >> 9) & 1) << 5)); }
__host__ __device__ __forceinline__ void stage_rc(int b, int& R, int& C) { const int st = b / 1024, sb = b % 1024, swz = sb ^ (((sb >> 9) & 1) << 5); R = (st >> 1) * 16 + swz / 64; C = (st & 1) * 32 + (swz % 64) / 2; }
__host__ __device__ __forceinline__ int perm32(int rho) { const int n = rho >> 4, i = rho & 15; return 8 * (i >> 2) + 4 * n + (i & 3); }

struct Unit { int pm, pn; };
struct Gemm { const bf16_t* A; const bf16_t* Bt; int M, N, K; int ablk = 0; };

struct StaticOrder {
    int nM, nN, nwg, G, c, wgm;
    __host__ __device__ void init(int M, int N, int G_, int c_, int wgm_ = WGM) { nM = M / BM; nN = N / BM; nwg = nM * nN; G = G_; c = c_; wgm = wgm_; }
    __host__ __device__ bool next(int i, Unit& u) const {
        const long L = (long)i * G + c; if (L >= nwg) return false;
        int wgid = (int)L; { const int q = nwg / NXCD, r = nwg % NXCD, xcd = wgid % NXCD, off = wgid / NXCD; wgid = (xcd < r ? xcd * (q + 1) : r * (q + 1) + (xcd - r) * q) + off; }
        const int nig = wgm * nN, gid = wgid / nig, fm = gid * wgm, gsz = (nM - fm) < wgm ? (nM - fm) : wgm;
        u.pm = fm + ((wgid % nig) % gsz); u.pn = (wgid % nig) / gsz; return true;
    }
    __device__ __forceinline__ void a_ready(const Unit&) const {}
    __device__ __forceinline__ void done(const Unit&) const {}
};

__device__ __forceinline__ unsigned cvt_pk_bf16(float lo, float hi) { unsigned r; asm volatile("v_cvt_pk_bf16_f32 %0, %1, %2" : "=v"(r) : "v"(lo), "v"(hi)); return r; }
typedef float f32x2 __attribute__((ext_vector_type(2)));
__device__ __forceinline__ float bf_lo(unsigned w) { return __uint_as_float(w << 16); }
__device__ __forceinline__ float bf_hi(unsigned w) { return __uint_as_float(w & 0xffff0000u); }
__device__ __forceinline__ float sigmoidf_(float x) { return __builtin_amdgcn_rcpf(1.0f + __expf(-x)); }

struct EpiProj {
    static constexpr bool PERM = true, AFTER_DRAIN = false, HAS_MID = false;
    bf16_t *Q, *Kb, *Vb, *ZA, *U, *ZS; const float *cos_t, *sin_t, *qnw, *knw;
    __device__ __forceinline__ void mid(f32x4 (&acc)[2][2][4][2], const Unit&, int, int, int, int, int, int, int, PG8_LAS unsigned char*) const {}
    __device__ __forceinline__ void operator()(const f32x4 (&acc)[2][2][4][2], const Unit& u, int ui, int wr, int wc, int fr, int fq, PG8_LAS unsigned char* lds) const {
        const int row0 = u.pm * BM + wr * 64 + fr; const int pn = u.pn;
        if (pn <= 4) {
            const float* nw = pn < 4 ? qnw : knw; bf16_t* base = pn < 4 ? Q + (pn * 4 + wc) * 64 : Kb + wc * 64; const int ldc = pn < 4 ? 1024 : 256;
            const float osc = pn < 4 ? 0.125f * 1.4426950408889634f : 1.0f;
            const f32x4 w1a = *(const f32x4*)(nw + 8 * fq), w1b = *(const f32x4*)(nw + 8 * fq + 4), w2a = *(const f32x4*)(nw + 32 + 8 * fq), w2b = *(const f32x4*)(nw + 32 + 8 * fq + 4);
#pragma unroll
            for (int ai = 0; ai < 2; ++ai)
#pragma unroll
                for (int m = 0; m < 4; ++m) { const int row = row0 + ai * HALF + m * 16;
                    const f32x4 x1a = acc[ai][0][m][0], x1b = acc[ai][0][m][1], x2a = acc[ai][1][m][0], x2b = acc[ai][1][m][1];
                    const f32x4 ca = *(const f32x4*)(cos_t + (size_t)row * 32 + 8 * fq), cb = *(const f32x4*)(cos_t + (size_t)row * 32 + 8 * fq + 4), sa = *(const f32x4*)(sin_t + (size_t)row * 32 + 8 * fq), sb = *(const f32x4*)(sin_t + (size_t)row * 32 + 8 * fq + 4);
                    float ss = 0.f;
#pragma unroll
                    for (int e = 0; e < 4; ++e) ss += x1a[e] * x1a[e] + x1b[e] * x1b[e] + x2a[e] * x2a[e] + x2b[e] * x2b[e];
                    ss += __shfl_xor(ss, 16); ss += __shfl_xor(ss, 32);
                    const float rstd = (1.0f / sqrtf(ss * (1.f / 64.f) + 1e-6f)) * osc;
                    const f32x4 a_a = x1a * rstd * w1a, a_b = x1b * rstd * w1b, b_a = x2a * rstd * w2a, b_b = x2b * rstd * w2b;
                    const f32x4 o1a = a_a * ca - b_a * sa, o1b = a_b * cb - b_b * sb, o2a = b_a * ca + a_a * sa, o2b = b_b * cb + a_b * sb;
                    u32x4 w1, w2; w1.x = cvt_pk_bf16(o1a[0], o1a[1]); w1.y = cvt_pk_bf16(o1a[2], o1a[3]); w1.z = cvt_pk_bf16(o1b[0], o1b[1]); w1.w = cvt_pk_bf16(o1b[2], o1b[3]);
                    w2.x = cvt_pk_bf16(o2a[0], o2a[1]); w2.y = cvt_pk_bf16(o2a[2], o2a[3]); w2.z = cvt_pk_bf16(o2b[0], o2b[1]); w2.w = cvt_pk_bf16(o2b[2], o2b[3]);
                    bf16_t* p = base + (size_t)row * ldc + 8 * fq; *(u32x4*)p = w1; *(u32x4*)(p + 32) = w2; }
            return; }
        bf16_t* base; int ldc, colt; bool isU = false;
        if (pn == 5) { base = Vb; ldc = 256; colt = 0; }
        else if (pn < 10) { base = ZA; ldc = 1024; colt = (pn - 6) * 256; }
        else if (pn < 14) { base = U; ldc = 1024; colt = (pn - 10) * 256; isU = true; }
        else { base = ZS; ldc = 1024; colt = (pn - 14) * 256; }
        const int col0 = colt + wc * 32 + 8 * fq;
#pragma unroll
        for (int ai = 0; ai < 2; ++ai)
#pragma unroll
            for (int m = 0; m < 4; ++m) { const int row = row0 + ai * HALF + m * 16;
#pragma unroll
                for (int bj = 0; bj < 2; ++bj) { const f32x4 v0 = acc[ai][bj][m][0], v1 = acc[ai][bj][m][1]; const int col = col0 + bj * HALF;
                    u32x4 w; w.x = cvt_pk_bf16(v0[0], v0[1]); w.y = cvt_pk_bf16(v0[2], v0[3]); w.z = cvt_pk_bf16(v1[0], v1[1]); w.w = cvt_pk_bf16(v1[2], v1[3]);
                    bf16_t* p;
                    if (isU) { const int b = row >> 12, t = row & 4095, g = col >> 4, hi8 = (col >> 3) & 1; p = base + ((size_t)((((b * 64 + g) * 4 + (t >> 10)) * 32 + (t & 31)) * 64 + hi8 * 32 + ((t >> 5) & 31))) * 8; }
                    else p = base + (size_t)row * ldc + col;
                    *(u32x4*)p = w; } }
    }
};
struct EpiGlu {
    static constexpr bool PERM = true, AFTER_DRAIN = false, HAS_MID = false;
    const bf16_t* YG; const bf16_t* ZS; const float* bias; bf16_t* MG; float* rsq;
    __device__ __forceinline__ void mid(f32x4 (&acc)[2][2][4][2], const Unit&, int, int, int, int, int, int, int, PG8_LAS unsigned char*) const {}
    __device__ __forceinline__ void operator()(const f32x4 (&acc)[2][2][4][2], const Unit& u, int ui, int wr, int wc, int fr, int fq, PG8_LAS unsigned char* lds) const {
        const int row0 = u.pm * BM + wr * 64 + fr; const int col0 = u.pn * BM + wc * 32 + 8 * fq;
        f32x4 bv[2][2];
#pragma unroll
        for (int bj = 0; bj < 2; ++bj)
#pragma unroll
            for (int n = 0; n < 2; ++n) bv[bj][n] = *(const f32x4*)(bias + col0 + bj * HALF + 4 * n);
#pragma unroll
        for (int ai = 0; ai < 2; ++ai)
#pragma unroll
            for (int m = 0; m < 4; ++m) { const int row = row0 + ai * HALF + m * 16; float ss = 0.f;
#pragma unroll
                for (int bj = 0; bj < 2; ++bj) { const int col = col0 + bj * HALF;
                    const u32x4 yv = *(const u32x4*)(YG + ((size_t)(col >> 4) * M + row) * 16 + (col & 15)), zv = *(const u32x4*)(ZS + (size_t)row * 1024 + col);
                    const f32x4 g0 = acc[ai][bj][m][0] + bv[bj][0], g1 = acc[ai][bj][m][1] + bv[bj][1];
                    float o[8];
#pragma unroll
                    for (int e = 0; e < 8; ++e) { const unsigned yw = yv[e >> 1], zw = zv[e >> 1]; const float y = (e & 1) ? bf_hi(yw) : bf_lo(yw), z = (e & 1) ? bf_hi(zw) : bf_lo(zw);
                        const float gt = e < 4 ? g0[e & 3] : g1[e & 3]; o[e] = y * sigmoidf_(gt) * z * sigmoidf_(z); ss += o[e] * o[e]; }
                    u32x4 w; w.x = cvt_pk_bf16(o[0], o[1]); w.y = cvt_pk_bf16(o[2], o[3]); w.z = cvt_pk_bf16(o[4], o[5]); w.w = cvt_pk_bf16(o[6], o[7]);
                    *(u32x4*)(MG + (size_t)row * 2048 + 1024 + col) = w; }
                ss += __shfl_xor(ss, 16); ss += __shfl_xor(ss, 32);
                if (fq == 0) rsq[(size_t)row * 16 + u.pn * 4 + wc] = ss; }
    }
};
struct EpiOut {
    static constexpr bool PERM = false, AFTER_DRAIN = false, HAS_MID = true;
    const float* X; float* OUT;
    template <int E> __device__ __forceinline__ void cons1(f32x4 (&acc)[2][2][4][2], const f32x4 x0, const f32x4 x1, bool first_half, const PG8_LAS f32x2* tab, int wr, int fr) const {
        constexpr int ai = E >> 3, bj = (E >> 2) & 1, m = E & 3; const f32x2 tv = tab[ai * HALF + wr * 64 + m * 16 + fr];
        const float f = __builtin_amdgcn_rcpf(first_half ? tv.x * tv.y : tv.y);
        acc[ai][bj][m][0] = acc[ai][bj][m][0] + x0 * f; acc[ai][bj][m][1] = acc[ai][bj][m][1] + x1 * f;
        asm volatile("" : "+v"(acc[ai][bj][m][0]), "+v"(acc[ai][bj][m][1]));
    }
    __device__ __forceinline__ void consume(f32x4 (&acc)[2][2][4][2], const f32x4 x0, const f32x4 x1, int ec, bool first_half, const PG8_LAS f32x2* tab, int wr, int fr) const {
        switch (ec) {
            case 0: cons1<0>(acc, x0, x1, first_half, tab, wr, fr); break;   case 1: cons1<1>(acc, x0, x1, first_half, tab, wr, fr); break;
            case 2: cons1<2>(acc, x0, x1, first_half, tab, wr, fr); break;   case 3: cons1<3>(acc, x0, x1, first_half, tab, wr, fr); break;
            case 4: cons1<4>(acc, x0, x1, first_half, tab, wr, fr); break;   case 5: cons1<5>(acc, x0, x1, first_half, tab, wr, fr); break;
            case 6: cons1<6>(acc, x0, x1, first_half, tab, wr, fr); break;   case 7: cons1<7>(acc, x0, x1, first_half, tab, wr, fr); break;
            case 8: cons1<8>(acc, x0, x1, first_half, tab, wr, fr); break;   case 9: cons1<9>(acc, x0, x1, first_half, tab, wr, fr); break;
            case 10: cons1<10>(acc, x0, x1, first_half, tab, wr, fr); break; case 11: cons1<11>(acc, x0, x1, first_half, tab, wr, fr); break;
            case 12: cons1<12>(acc, x0, x1, first_half, tab, wr, fr); break; case 13: cons1<13>(acc, x0, x1, first_half, tab, wr, fr); break;
            case 14: cons1<14>(acc, x0, x1, first_half, tab, wr, fr); break; case 15: cons1<15>(acc, x0, x1, first_half, tab, wr, fr); break;
            default: break; }
    }
    __device__ __forceinline__ void mid(f32x4 (&acc)[2][2][4][2], const Unit& u, int ui, int t, int nt, int wr, int wc, int fr, int fq, PG8_LAS unsigned char* lds) const {
        const int h = nt / 2;
        const PG8_LAS f32x2* tab = (const PG8_LAS f32x2*)(lds + TAB_OFF) + ui * 256;
        if (t == h) {
#pragma unroll
            for (int ai = 0; ai < 2; ++ai)
#pragma unroll
                for (int m = 0; m < 4; ++m) { const float ratio = tab[ai * HALF + wr * 64 + m * 16 + fr].x;
#pragma unroll
                    for (int bj = 0; bj < 2; ++bj)
#pragma unroll
                        for (int n = 0; n < 2; ++n) acc[ai][bj][m][n] = acc[ai][bj][m][n] * ratio; } }
        const int ei = (t * 16) / nt;
        { unsigned ln; asm volatile("v_mbcnt_lo_u32_b32 %0, -1, 0\n\tv_mbcnt_hi_u32_b32 %0, -1, %0" : "=v"(ln)); fr = (int)(ln & 15u); fq = (int)(ln >> 4); }
        PG8_LAS unsigned char* slot = lds + XP_OFF + (wr * 4 + wc) * 2048;
        if (ei > 0) { const f32x4 x0 = *(const PG8_LAS f32x4*)(slot + (fq * 16 + fr) * 16), x1 = *(const PG8_LAS f32x4*)(slot + 1024 + (fq * 16 + fr) * 16);
            consume(acc, x0, x1, ei - 1, t < h, tab, wr, fr); }
        { const int ai = ei >> 3, bj = (ei >> 2) & 1, m = ei & 3;
          const char* pu = (const char*)(X + (size_t)(u.pm * BM + ai * HALF + m * 16) * 2048 + u.pn * BM + bj * HALF);
          const unsigned vo = (unsigned)((wr * 64 + fr) * 2048 + wc * 32 + 4 * fq) * 4u;
          asm volatile("s_waitcnt lgkmcnt(0)" ::: "memory");
          __builtin_amdgcn_global_load_lds((const unsigned*)(pu + vo), (PG8_LAS unsigned*)slot, 16, 0, 0);
          __builtin_amdgcn_global_load_lds((const unsigned*)(pu + vo + 64), (PG8_LAS unsigned*)(slot + 1024), 16, 0, 0); }
    }
    __device__ __forceinline__ void operator()(f32x4 (&acc)[2][2][4][2], const Unit& u, int ui, int wr, int wc, int fr, int fq, PG8_LAS unsigned char* lds) const {
        const PG8_LAS f32x2* tab = (const PG8_LAS f32x2*)(lds + TAB_OFF) + ui * 256;
        { const PG8_LAS unsigned char* slot = lds + XP_OFF + (wr * 4 + wc) * 2048; const f32x4 x0 = *(const PG8_LAS f32x4*)(slot + (fq * 16 + fr) * 16), x1 = *(const PG8_LAS f32x4*)(slot + 1024 + (fq * 16 + fr) * 16);
          cons1<15>(acc, x0, x1, false, tab, wr, fr); }
        const int col0 = u.pn * BM + wc * 32 + 4 * fq;
#pragma unroll
        for (int ai = 0; ai < 2; ++ai)
#pragma unroll
            for (int m = 0; m < 4; ++m) { const int r = ai * HALF + wr * 64 + m * 16 + fr; const float rs = tab[r].y; const size_t off = (size_t)(u.pm * BM + r) * 2048 + col0;
#pragma unroll
                for (int bj = 0; bj < 2; ++bj)
#pragma unroll
                    for (int n = 0; n < 2; ++n) *(f32x4*)(OUT + off + bj * HALF + n * 16) = acc[ai][bj][m][n] * rs; }
    }
};

template <class Epi, class Sched, bool ALIGN_EPI = false, bool SP2 = false>
__device__ __forceinline__ void gemm_phase(PG8_LAS unsigned char* lds, const Gemm g, const Sched& S, const Epi& E) {
    const int tid = threadIdx.x, wid = __builtin_amdgcn_readfirstlane(tid >> 6), lane = tid & 63, wr = wid >> 2, wc = wid & 3, fr = lane & 15, fq = lane >> 4;
    const int K = g.K, nt = K / BK;
    unsigned voffA[2], voffB[2];
#pragma unroll
    for (int i = 0; i < 2; ++i) { int R, C; stage_rc(tid * 16 + i * 8192, R, C); const int Rb = Epi::PERM ? ((R & ~31) + perm32(R & 31)) : R;
        voffA[i] = g.ablk ? (unsigned)(((C >> 4) * g.M + R) * 16 + (C & 15)) * 2u : (unsigned)(R * K + C) * 2u; voffB[i] = (unsigned)(Rb * K + C) * 2u; }
    const size_t kstep = (size_t)(BK * 2);
    const size_t hstep = (size_t)HALF * K * 2;
    const size_t tstep = 2 * hstep;
    const size_t kstepA = g.ablk ? (size_t)4 * g.M * 32 : kstep, hstepA = g.ablk ? (size_t)HALF * 32 : hstep, tstepA = 2 * hstepA;
    const unsigned ldsw = (unsigned)wid * 1024u;
    const int aoff = lds_byte(wr * 64 + fr, fq * 8), boff = lds_byte(wc * 32 + fr, fq * 8);
#define PG8_SA(b, h) (((b) * 2 + (h)) * HTB)
#define PG8_SB(b, h) ((4 + (b) * 2 + (h)) * HTB)
#define PG8_STAGE(bufoff, gbase, voff) do { _Pragma("unroll") for (int _i = 0; _i < 2; ++_i) \
        __builtin_amdgcn_global_load_lds((const unsigned*)((const char*)(gbase) + (voff)[_i]), (PG8_LAS unsigned*)(lds + (bufoff) + ldsw + _i * 8192), 16, 0, 0); } while (0)
#define PG8_LDA(dst, b, h) do { _Pragma("unroll") for (int m = 0; m < 4; ++m) _Pragma("unroll") for (int k = 0; k < 2; ++k) dst[m][k] = *(const PG8_LAS bf16x8*)(lds + PG8_SA(b, h) + aoff + m * 2048 + k * 1024); } while (0)
#define PG8_LDB(dst, b, h) do { _Pragma("unroll") for (int n = 0; n < 2; ++n) _Pragma("unroll") for (int k = 0; k < 2; ++k) dst[n][k] = *(const PG8_LAS bf16x8*)(lds + PG8_SB(b, h) + boff + n * 2048 + k * 1024); } while (0)
#define PG8_MMA(ai, bj, At, Bt) do { __builtin_amdgcn_s_setprio(1); _Pragma("unroll") for (int m = 0; m < 4; ++m) _Pragma("unroll") for (int n = 0; n < 2; ++n) _Pragma("unroll") for (int k = 0; k < 2; ++k) \
        acc[ai][bj][m][n] = __builtin_amdgcn_mfma_f32_16x16x32_bf16(Bt[n][k], At[m][k], acc[ai][bj][m][n], 0, 0, 0); __builtin_amdgcn_s_setprio(0); } while (0)
#define PG8_WAIT_V(n) asm volatile("s_waitcnt vmcnt(" #n ")" ::: "memory")
#define PG8_WAIT_L(n) asm volatile("s_waitcnt lgkmcnt(" #n ")" ::: "memory")
#define PG8_BAR __builtin_amdgcn_s_barrier()
#define PG8_SCHED __builtin_amdgcn_sched_barrier(0)
    Unit cur, nxt; int ui = 0;
    if (!S.next(0, cur)) return;
    f32x4 acc[2][2][4][2];
#pragma unroll
    for (int a = 0; a < 2; ++a)
#pragma unroll
        for (int b = 0; b < 2; ++b)
#pragma unroll
            for (int m = 0; m < 4; ++m)
#pragma unroll
                for (int n = 0; n < 2; ++n) acc[a][b][m][n] = (f32x4){0.f, 0.f, 0.f, 0.f};
    bf16x8 At[4][2], B0[2][2], B1[2][2];
    const char* cA = (const char*)g.A + (size_t)cur.pm * tstepA; const char* cB = (const char*)g.Bt + (size_t)cur.pn * tstep;
    S.a_ready(cur);
    if constexpr (SP2) {
        PG8_STAGE(PG8_SB(0, 0), cB, voffB); PG8_STAGE(PG8_SB(0, 1), cB + hstep, voffB); PG8_STAGE(PG8_SA(0, 0), cA, voffA); PG8_STAGE(PG8_SA(0, 1), cA + hstepA, voffA);
        if (wr == 1) PG8_BAR;
        PG8_WAIT_V(2); PG8_BAR;
        PG8_STAGE(PG8_SB(1, 0), cB + kstep, voffB); PG8_STAGE(PG8_SA(1, 0), cA + kstepA, voffA); PG8_STAGE(PG8_SB(1, 1), cB + hstep + kstep, voffB);
        PG8_WAIT_V(6); PG8_BAR;
    } else {
        PG8_STAGE(PG8_SB(0, 0), cB, voffB); PG8_STAGE(PG8_SA(0, 0), cA, voffA); PG8_STAGE(PG8_SB(0, 1), cB + hstep, voffB); PG8_STAGE(PG8_SA(0, 1), cA + hstepA, voffA);
        if (wr == 1) PG8_BAR;
        PG8_WAIT_V(4); PG8_BAR;
        PG8_STAGE(PG8_SB(1, 0), cB + kstep, voffB); PG8_STAGE(PG8_SA(1, 0), cA + kstepA, voffA); PG8_STAGE(PG8_SB(1, 1), cB + hstep + kstep, voffB);
        PG8_WAIT_V(6); PG8_BAR;
    }
    for (;;) {
        const bool has_next = S.next(ui + 1, nxt);
        const char* nA = has_next ? (const char*)g.A + (size_t)nxt.pm * tstepA : cA; const char* nB = has_next ? (const char*)g.Bt + (size_t)nxt.pn * tstep : cB;
        for (int t = 0; t < nt; t += 2) {
            if constexpr (Epi::HAS_MID) E.mid(acc, cur, ui, t, nt, wr, wc, fr, fq, lds);
            const bool last = (t == nt - 2);
            const char* a1 = cA + (size_t)(t + 1) * kstepA;
            const char* a2 = last ? nA : cA + (size_t)(t + 2) * kstepA; const char* b2 = last ? nB : cB + (size_t)(t + 2) * kstep;
            const char* a3 = a2 + kstepA; const char* b3 = b2 + kstep;
            if (last && has_next) S.a_ready(nxt);
            if constexpr (SP2) {
            PG8_LDB(B0, 0, 0); PG8_LDB(B1, 0, 1); PG8_SCHED; PG8_LDA(At, 0, 0); PG8_STAGE(PG8_SA(1, 1), a1 + hstepA, voffA);
            PG8_WAIT_V(8); PG8_WAIT_L(0); PG8_BAR; PG8_MMA(0, 0, At, B0); PG8_MMA(0, 1, At, B1); PG8_BAR; PG8_SCHED;
            PG8_LDA(At, 0, 1); PG8_STAGE(PG8_SB(0, 0), b2, voffB); PG8_STAGE(PG8_SB(0, 1), b2 + hstep, voffB); PG8_STAGE(PG8_SA(0, 0), a2, voffA);
            PG8_WAIT_V(8); PG8_WAIT_L(0); PG8_BAR; PG8_MMA(1, 0, At, B0); PG8_MMA(1, 1, At, B1); PG8_BAR; PG8_SCHED;
            PG8_LDB(B0, 1, 0); PG8_LDB(B1, 1, 1); PG8_SCHED; PG8_LDA(At, 1, 0); PG8_STAGE(PG8_SA(0, 1), a2 + hstepA, voffA);
            PG8_WAIT_V(8); PG8_WAIT_L(0); PG8_BAR; PG8_MMA(0, 0, At, B0); PG8_MMA(0, 1, At, B1); PG8_BAR; PG8_SCHED;
            PG8_LDA(At, 1, 1); PG8_STAGE(PG8_SB(1, 0), b3, voffB); PG8_STAGE(PG8_SB(1, 1), b3 + hstep, voffB); PG8_STAGE(PG8_SA(1, 0), a3, voffA);
            PG8_WAIT_V(8); PG8_WAIT_L(0); PG8_BAR; PG8_MMA(1, 0, At, B0); PG8_MMA(1, 1, At, B1); PG8_BAR; PG8_SCHED;
            } else {
            PG8_LDB(B0, 0, 0); PG8_SCHED; PG8_LDA(At, 0, 0); PG8_STAGE(PG8_SA(1, 1), a1 + hstepA, voffA);
            PG8_WAIT_L(8); PG8_BAR; PG8_WAIT_L(0); PG8_MMA(0, 0, At, B0); PG8_BAR; PG8_SCHED;
            PG8_LDB(B1, 0, 1); PG8_STAGE(PG8_SB(0, 0), b2, voffB);
            PG8_BAR; PG8_WAIT_L(0); PG8_MMA(0, 1, At, B1); PG8_BAR;
            PG8_LDA(At, 0, 1); PG8_STAGE(PG8_SA(0, 0), a2, voffA);
            PG8_BAR; PG8_WAIT_L(0); PG8_MMA(1, 0, At, B0); PG8_BAR; PG8_SCHED;
            PG8_STAGE(PG8_SB(0, 1), b2 + hstep, voffB);
            PG8_WAIT_V(6); PG8_BAR; PG8_MMA(1, 1, At, B1); PG8_BAR;
            PG8_LDB(B0, 1, 0); PG8_SCHED; PG8_LDA(At, 1, 0); PG8_STAGE(PG8_SA(0, 1), a2 + hstepA, voffA);
            PG8_WAIT_L(8); PG8_BAR; PG8_WAIT_L(0); PG8_MMA(0, 0, At, B0); PG8_BAR; PG8_SCHED;
            PG8_LDB(B1, 1, 1); PG8_STAGE(PG8_SB(1, 0), b3, voffB);
            PG8_BAR; PG8_WAIT_L(0); PG8_MMA(0, 1, At, B1); PG8_BAR;
            PG8_LDA(At, 1, 1); PG8_STAGE(PG8_SA(1, 0), a3, voffA);
            PG8_BAR; PG8_WAIT_L(0); PG8_MMA(1, 0, At, B0); PG8_BAR; PG8_SCHED;
            PG8_STAGE(PG8_SB(1, 1), b3 + hstep, voffB);
            PG8_WAIT_V(6); PG8_BAR; PG8_MMA(1, 1, At, B1); PG8_BAR;
            }
        }
        if constexpr (ALIGN_EPI) { if (wr == 0) PG8_BAR; }
        E(acc, cur, ui, wr, wc, fr, fq, lds); S.done(cur);
        if (!has_next) break;
#pragma unroll
        for (int a = 0; a < 2; ++a)
#pragma unroll
            for (int b = 0; b < 2; ++b)
#pragma unroll
                for (int m = 0; m < 4; ++m)
#pragma unroll
                    for (int n = 0; n < 2; ++n) acc[a][b][m][n] = (f32x4){0.f, 0.f, 0.f, 0.f};
        cur = nxt; cA = nA; cB = nB; ++ui;
        if constexpr (ALIGN_EPI) { if (wr == 1) PG8_BAR; }
    }
    PG8_WAIT_V(0);
    if constexpr (!ALIGN_EPI) { if (wr == 0) PG8_BAR; }
    PG8_BAR;

#undef PG8_SA
#undef PG8_SB
#undef PG8_STAGE
#undef PG8_LDA
#undef PG8_LDB
#undef PG8_MMA
#undef PG8_WAIT_V
#undef PG8_WAIT_L
#undef PG8_BAR
#undef PG8_SCHED
}
}
constexpr int NWAVES = 8;
#ifndef MK_N_LAUNCHES
#define MK_N_LAUNCHES 1
#endif
constexpr int N_LAUNCHES = MK_N_LAUNCHES;
constexpr int PER_PHASE = 5;

constexpr size_t MiB = 1u << 20;
constexpr size_t WS_CTL = 0, CTL_ZERO_BYTES = 1 * MiB;
constexpr size_t WS_WIN = 2 * MiB, WS_WGLU = 20 * MiB, WS_WOUT = 22 * MiB;
constexpr size_t WS_ROPE = 30 * MiB;
constexpr size_t WS_RSQA = 34 * MiB, WS_RSQS = 35 * MiB;
constexpr size_t WS_SSMT = 36 * MiB, SSM_GSTRIDE = 327680;
constexpr size_t SSM_OFF_T = 0, SSM_OFF_WIN = 36864, SSM_OFF_WOUT = 167936, SSM_OFF_W32 = 299008;
constexpr size_t WS_XN = 64 * MiB;
constexpr size_t WS_Q = 128 * MiB, WS_K = 160 * MiB, WS_V = 168 * MiB, WS_ZA = 176 * MiB, WS_U = 208 * MiB, WS_ZS = 240 * MiB;
constexpr size_t WS_YG = 272 * MiB, WS_MG = 304 * MiB, WS_END = 368 * MiB;
static_assert(WS_SSMT + 64 * SSM_GSTRIDE <= WS_XN, "d_ws map");
constexpr int CW_TMO = 0, CW_CODE = 1, CW_BAR = 4096;

constexpr int RING_OFF = 0, RING_BYTES = 131072;
constexpr int LDSCTL_OFF = 163328, MISC_OFF = LDSCTL_OFF + 320;
constexpr int LDS_BYTES = 163840;

#define GAS __attribute__((address_space(1)))
#define LAS __attribute__((address_space(3)))
typedef unsigned short bf16;
typedef unsigned v4u __attribute__((ext_vector_type(4)));
typedef float f32x4 __attribute__((ext_vector_type(4)));
typedef short bf16x8 __attribute__((ext_vector_type(8)));
typedef GAS unsigned gu32;
typedef GAS unsigned long long gu64;
#define RLX_AGENT __ATOMIC_RELAXED, __HIP_MEMORY_SCOPE_AGENT
#define LDS_WAIT() asm volatile("s_waitcnt lgkmcnt(0)" ::: "memory")
#define VM_WAIT() asm volatile("s_waitcnt vmcnt(0)" ::: "memory")
__device__ __forceinline__ unsigned long long rt() { return __builtin_amdgcn_s_memrealtime(); }
__device__ __forceinline__ unsigned f2bf(float f) { unsigned u = __builtin_bit_cast(unsigned, f); return (u + 0x7fffu + ((u >> 16) & 1u)) >> 16; }
__device__ __forceinline__ unsigned pk2(float lo, float hi) { return f2bf(lo) | (f2bf(hi) << 16); }

#define XB_TMO      128
#define XB_XCNT(j)  (256  + 64 * (j))
#define XB_XSUB(j)  (1280 + 64 * (j))
#define XB_XGEN(j)  (2304 + 64 * (j))
#define XB_TOP      3328
#define XB_TOPGEN   3392
#define XCD_BAR_WORDS 3456
#define XB_SPIN_CAP (1u << 18)

__device__ __forceinline__ unsigned xb_ld(unsigned* p)              { return __hip_atomic_load(p, __ATOMIC_RELAXED, __HIP_MEMORY_SCOPE_AGENT); }
__device__ __forceinline__ unsigned xb_add(unsigned* p, unsigned v) { return __hip_atomic_fetch_add(p, v, __ATOMIC_RELAXED, __HIP_MEMORY_SCOPE_AGENT); }
__device__ __forceinline__ unsigned xb_xcc_id() { return (unsigned)__builtin_amdgcn_s_getreg((3 << 11) | 20) & 0xFu; }
#define XB_SPIN(cond, bar) do { unsigned _sp = 0; while (cond) { __builtin_amdgcn_s_sleep(16); \
    if ((++_sp & 255u) == 0u) { if (xb_ld(&(bar)[XB_TMO])) break; if (_sp > XB_SPIN_CAP) { atomicAdd(&(bar)[XB_TMO], 1u); break; } } } } while (0)

struct XcdBarrier {
    unsigned* bar; unsigned x;
    volatile LAS unsigned* st;
};

__device__ __forceinline__ XcdBarrier xcd_barrier_post(unsigned* bar, volatile LAS unsigned* st) {
    XcdBarrier b; b.bar = bar; b.x = xb_xcc_id(); b.st = st;
    if (threadIdx.x == 0) (void)xb_add(&bar[XB_XCNT(b.x)], 1u);
    return b;
}
__device__ __forceinline__ void xcd_barrier_complete(unsigned* bar, unsigned x, unsigned& nloc, unsigned& nx) {
    const unsigned G = gridDim.x * gridDim.y * gridDim.z;
    unsigned sum, cnt, mine, sp = 0u;
    for (;;) {
        sum = 0u; cnt = 0u; mine = 0u;
#pragma unroll
        for (unsigned j = 0; j < 16; ++j) { const unsigned c = xb_ld(&bar[XB_XCNT(j)]); sum += c; cnt += (c > 0u) ? 1u : 0u; mine = (j == x) ? c : mine; }
        if (sum == G) break;
        __builtin_amdgcn_s_sleep(1);
        if ((++sp & 255u) == 0u) { if (xb_ld(&bar[XB_TMO])) break; if (sp > XB_SPIN_CAP) { atomicAdd(&bar[XB_TMO], 1u); break; } }
    }
    nloc = mine > 0u ? mine : 1u; nx = cnt > 0u ? cnt : 1u;
}

__device__ __forceinline__ void xcd_barrier(const XcdBarrier& b) {
    asm volatile("s_waitcnt vmcnt(0)" ::: "memory");
    __syncthreads();
    if (threadIdx.x == 0) {
        unsigned* bar = b.bar;
        __builtin_amdgcn_s_waitcnt(0);
        unsigned nloc = b.st[0], nx = b.st[1];
        if (nloc == 0u) { xcd_barrier_complete(bar, b.x, nloc, nx); b.st[0] = nloc; b.st[1] = nx; }
        const unsigned old = xb_add(&bar[XB_XSUB(b.x)], 1u);
        const unsigned gen = old / nloc;
        if (old + 1u == (gen + 1u) * nloc) {
            __builtin_amdgcn_fence(__ATOMIC_RELEASE, "agent");
            asm volatile("s_waitcnt vmcnt(0)" ::: "memory");
            const unsigned og = xb_add(&bar[XB_TOP], 1u);
            const unsigned tg = og / nx;
            if (og + 1u == (tg + 1u) * nx) xb_add(&bar[XB_TOPGEN], 1u);
            else XB_SPIN(xb_ld(&bar[XB_TOPGEN]) == tg, bar);
            __builtin_amdgcn_fence(__ATOMIC_ACQUIRE, "agent");
            xb_add(&bar[XB_XGEN(b.x)], 1u);
            asm volatile("s_waitcnt vmcnt(0)" ::: "memory");
        } else {
            XB_SPIN(xb_ld(&bar[XB_XGEN(b.x)]) == gen, bar);
            __builtin_amdgcn_fence(__ATOMIC_ACQUIRE, "agent");
            asm volatile("s_waitcnt vmcnt(0)" ::: "memory");
        }
    }
    __syncthreads();
}
struct Frame {
    LAS unsigned char* lds; volatile LAS unsigned* MISC; gu32* ctl;
    int tid, lane, wave, vcu, G;
    const float *x, *norm_w, *w_in, *q_norm_w, *k_norm_w, *sinks, *a_re, *a_im, *log_step, *b_re, *b_im, *c_re, *c_im, *d_skip, *w_glu, *b_glu, *anw, *snw, *w_out;
    const int* positions; float* out;
    bf16 *Win_t, *Wglu_t, *Wout_t, *XN, *Q, *KB, *VB, *ZA, *U, *ZS, *YG, *MG;
    float *cos_t, *sin_t, *rsq_a, *rsq_s; unsigned char* ssmt;
};
__device__ __forceinline__ float wave_sum(float v) {
#pragma unroll
    for (int o = 1; o < 64; o <<= 1) v += __shfl_xor(v, o);
    return v;
}
__device__ __forceinline__ float wave_max(float v) {
#pragma unroll
    for (int o = 1; o < 64; o <<= 1) v = fmaxf(v, __shfl_xor(v, o));
    return v;
}
__device__ __forceinline__ float bf2f(bf16 v) { return __uint_as_float((unsigned)v << 16); }
__device__ __forceinline__ double exp_d(double x) {
    const double k = rint(x * 1.4426950408889634); const double r = (x - k * 6.93147180369123816490e-01) - k * 1.90821492927058770002e-10;
    double p = 1.0 / 6227020800.0;
    p = p * r + 1.0 / 479001600.0; p = p * r + 1.0 / 39916800.0; p = p * r + 1.0 / 3628800.0; p = p * r + 1.0 / 362880.0; p = p * r + 1.0 / 40320.0; p = p * r + 1.0 / 5040.0;
    p = p * r + 1.0 / 720.0; p = p * r + 1.0 / 120.0; p = p * r + 1.0 / 24.0; p = p * r + 1.0 / 6.0; p = p * r + 0.5; p = p * r + 1.0; p = p * r + 1.0;
    return __builtin_ldexp(p, (int)k);
}
__device__ __forceinline__ void sincos_d(double x, double& c, double& s) {
    const double k = rint(x * 0.63661977236758134308); const double r = (x - k * 1.57079632673412561417e+00) - k * 6.07710050650619224932e-11; const double r2 = r * r;
    double ps = -1.0 / 6227020800.0; ps = ps * r2 + 1.0 / 39916800.0; ps = ps * r2 - 1.0 / 362880.0; ps = ps * r2 + 1.0 / 5040.0; ps = ps * r2 - 1.0 / 120.0; ps = ps * r2 + 1.0 / 6.0; ps = r - r * r2 * ps;
    double pc = 1.0 / 87178291200.0; pc = pc * r2 - 1.0 / 479001600.0; pc = pc * r2 + 1.0 / 3628800.0; pc = pc * r2 - 1.0 / 40320.0; pc = pc * r2 + 1.0 / 720.0; pc = pc * r2 - 1.0 / 24.0; pc = pc * r2 + 0.5; pc = 1.0 - r2 * pc;
    const int q = (int)((long long)k & 3);
    c = (q == 0) ? pc : (q == 1) ? -ps : (q == 2) ? -pc : ps;
    s = (q == 0) ? ps : (q == 1) ? pc : (q == 2) ? -ps : -pc;
}
__device__ __forceinline__ float inv_freq_f(int f) { return (float)exp_d(-(double)f * (9.210340371976184 / 32.0)); }

template <bool QKPERM = false> __device__ __forceinline__ void p0_transpose_item(const float* W, int K, int N, bf16* WT, const float* kscale, LAS float* scr, int item, int lane) {
    const int nblk = N / 64, kb = item / nblk, nb = item % nblk, k0 = 64 * kb, n0 = 64 * nb;
    const int lr = lane >> 4, lc = 4 * (lane & 15);
    f32x4 v[16];
#pragma unroll
    for (int i = 0; i < 16; ++i) v[i] = __builtin_nontemporal_load((const GAS f32x4*)(W + (size_t)(k0 + 4 * i + lr) * N + n0 + lc));
#pragma unroll
    for (int i = 0; i < 16; ++i) { const int kk = 4 * i + lr; f32x4 t = v[i]; if (kscale) t = t * kscale[k0 + kk]; LAS float* d = scr + kk * 65 + lc; d[0] = t.x; d[1] = t.y; d[2] = t.z; d[3] = t.w; }
    LDS_WAIT(); asm volatile("" ::: "memory");
    const int c = lane & 7;
#pragma unroll
    for (int j = 0; j < 8; ++j) { const int n = (lane >> 3) + 8 * j; const LAS float* s = scr + (8 * c) * 65 + n;
        v4u o; o.x = pk2(s[0 * 65], s[1 * 65]); o.y = pk2(s[2 * 65], s[3 * 65]); o.z = pk2(s[4 * 65], s[5 * 65]); o.w = pk2(s[6 * 65], s[7 * 65]);
        int nrow = n0 + n;
        if (QKPERM && nrow < AW + KVW) { const int tile = nrow & ~255, hh = (nrow >> 6) & 3, d = nrow & 63; nrow = tile + 128 * (d >> 5) + 32 * hh + (d & 31); }
        *(GAS v4u*)(WT + (size_t)nrow * K + k0 + 8 * c) = o; }
    LDS_WAIT(); asm volatile("" ::: "memory");
}
__device__ __forceinline__ void rms_rows2_to_bf16(const float* xrow, const float* nw, bf16* orow, int lane) {
    const GAS f32x4* xr = (const GAS f32x4*)xrow + lane; const GAS f32x4* wr = (const GAS f32x4*)nw + lane;
    f32x4 v[2][8]; float s[2] = {0.f, 0.f};
#pragma unroll
    for (int r = 0; r < 2; ++r)
#pragma unroll
        for (int j = 0; j < 8; ++j) v[r][j] = __builtin_nontemporal_load(xr + r * (DM / 4) + 64 * j);
#pragma unroll
    for (int r = 0; r < 2; ++r)
#pragma unroll
        for (int j = 0; j < 8; ++j) s[r] += (v[r][j].x * v[r][j].x + v[r][j].y * v[r][j].y) + (v[r][j].z * v[r][j].z + v[r][j].w * v[r][j].w);
    const float rstd0 = 1.0f / sqrtf(wave_sum(s[0]) * (1.f / DM) + EPS), rstd1 = 1.0f / sqrtf(wave_sum(s[1]) * (1.f / DM) + EPS);
    GAS unsigned long long* o8 = (GAS unsigned long long*)orow + lane;
#pragma unroll
    for (int j = 0; j < 8; ++j) { const f32x4 w = wr[64 * j]; const f32x4 a = v[0][j] * rstd0 * w, b = v[1][j] * rstd1 * w;
        o8[64 * j] = (unsigned long long)pk2(a.x, a.y) | ((unsigned long long)pk2(a.z, a.w) << 32);
        o8[(DM / 4) + 64 * j] = (unsigned long long)pk2(b.x, b.y) | ((unsigned long long)pk2(b.z, b.w) << 32); }
}
__device__ __forceinline__ void p0_ssm_tables(Frame& F, int g, int q) {
    typedef float f2 __attribute__((ext_vector_type(2)));
    LAS f2* pw = (LAS f2*)(F.lds + RING_OFF);
    LAS f2* bb = (LAS f2*)(F.lds + RING_OFF + 17408);
    LAS f2* cc = (LAS f2*)(F.lds + RING_OFF + 25600);
    const int tid = F.tid;
    __syncthreads();
    if (tid < 64) { const int p = tid;
        const double dl = exp_d((double)F.log_step[g]); const double ar = (double)F.a_re[g * 64 + p], ai = (double)F.a_im[g * 64 + p];
        const double mag = exp_d(ar * dl); double c, s; sincos_d(ai * dl, c, s); const double wr = mag * c, wi = mag * s;
        const double nr = wr - 1.0, ni = wi, den = ar * ar + ai * ai; const double cr = (nr * ar + ni * ai) / den, ci = (ni * ar - nr * ai) / den;
#pragma unroll
        for (int h = 0; h < 16; ++h) { const double br = (double)F.b_re[(g * 64 + p) * 16 + h], bi = (double)F.b_im[(g * 64 + p) * 16 + h]; bb[p * 16 + h] = (f2){(float)(cr * br - ci * bi), (float)(cr * bi + ci * br)}; }
        double pr = 1.0, pi = 0.0;
        for (int e = 0; e <= 32; ++e) { pw[e * 64 + p] = (f2){(float)pr, (float)pi}; const double n2 = pr * wr - pi * wi; pi = pr * wi + pi * wr; pr = n2; }
    }
    for (int i = tid; i < 1024; i += NWAVES * 64) { const int h = i >> 6, p = i & 63; cc[p * 16 + h] = (f2){F.c_re[g * 1024 + i], F.c_im[g * 1024 + i]}; }
    __syncthreads();
    unsigned char* base = F.ssmt + (size_t)g * SSM_GSTRIDE;
    {
        const int x = 512 * q + tid, dd = x >> 6, ln = x & 63, r32 = ln & 31, hi = ln >> 5, jj = r32 >> 4, h = r32 & 15, d = dd - 1 + jj;
        float v[8];
#pragma unroll
        for (int e = 0; e < 8; ++e) v[e] = 0.f;
        if (d >= 0 && d <= 31) {
#pragma unroll 4
            for (int p = 0; p < 64; ++p) { const f2 c = cc[p * 16 + h], w = pw[d * 64 + p]; const float mr = c.x * w.x - c.y * w.y, mi = c.x * w.y + c.y * w.x;
#pragma unroll
                for (int e = 0; e < 8; ++e) { const f2 b = bb[p * 16 + 8 * hi + e]; v[e] += mr * b.x - mi * b.y; } }
            if (d == 0) {
#pragma unroll
                for (int e = 0; e < 8; ++e) if (8 * hi + e == h) v[e] += F.d_skip[g * 16 + h]; }
        }
        v4u o; o.x = pk2(v[0], v[1]); o.y = pk2(v[2], v[3]); o.z = pk2(v[4], v[5]); o.w = pk2(v[6], v[7]);
        *(GAS v4u*)(base + SSM_OFF_T + (size_t)(dd * 64 + ln) * 16) = o; }
    for (int x = 2048 * q + tid; x < 2048 * (q + 1); x += NWAVES * 64) { const int ln = x & 63, i = (x >> 6) & 31, pt = x >> 11, r32 = ln & 31, hi = ln >> 5, pc = 32 * pt + r32, p = pc & 63, im = pc >> 6;
        const f2 w = pw[(31 - i) * 64 + p]; float v[8];
#pragma unroll
        for (int e = 0; e < 8; ++e) { const f2 b = bb[p * 16 + 8 * hi + e]; v[e] = im ? (w.x * b.y + w.y * b.x) : (w.x * b.x - w.y * b.y); }
        v4u o; o.x = pk2(v[0], v[1]); o.y = pk2(v[2], v[3]); o.z = pk2(v[4], v[5]); o.w = pk2(v[6], v[7]);
        *(GAS v4u*)(base + SSM_OFF_WIN + (size_t)((pt * 32 + i) * 64 + ln) * 16) = o; }
    for (int x = 2048 * q + tid; x < 2048 * (q + 1); x += NWAVES * 64) { const int ln = x & 63, ks = (x >> 6) & 7, rt = x >> 9, r32 = ln & 31, hi = ln >> 5, jj = r32 >> 4, h = r32 & 15, j = 2 * rt + jj;
        float v[8];
#pragma unroll
        for (int e = 0; e < 8; ++e) { const int pc = 16 * ks + 8 * hi + e, p = pc & 63, im = pc >> 6; const f2 c = cc[p * 16 + h], w = pw[(j + 1) * 64 + p];
            const float mr = c.x * w.x - c.y * w.y, mi = c.x * w.y + c.y * w.x; v[e] = im ? -mi : mr; }
        v4u o; o.x = pk2(v[0], v[1]); o.y = pk2(v[2], v[3]); o.z = pk2(v[4], v[5]); o.w = pk2(v[6], v[7]);
        *(GAS v4u*)(base + SSM_OFF_WOUT + (size_t)((rt * 8 + ks) * 64 + ln) * 16) = o; }
    if (q == 3 && tid < 64) *(GAS f2*)(base + SSM_OFF_W32 + tid * 8) = pw[32 * 64 + tid];
}
__device__ __forceinline__ void p0_prologue(Frame& F) {
    LAS float* scr = (LAS float*)(F.lds + RING_OFF + F.wave * 16640);
    const int gw = F.vcu * NWAVES + F.wave, NGW = F.G * NWAVES;
    constexpr int I_IN = (DM / 64) * (INW / 64);
    PAD_BEGIN(5);
    for (int it = gw; it < I_IN; it += NGW) p0_transpose_item<true>(F.w_in, DM, INW, F.Win_t, nullptr, scr, it, F.lane);
    PAD_END(5);
    if (F.G == 256) {
        const int xg = F.vcu >> 5, wx = (F.vcu & 31) * NWAVES + F.wave;
        for (int k = 0; k < 4; ++k) { const int m2 = 1024 * xg + wx + 256 * k; rms_rows2_to_bf16(F.x + (size_t)(2 * m2) * DM, F.norm_w, F.XN + (size_t)(2 * m2) * DM, F.lane); }
    } else for (int m2 = gw; m2 < M / 2; m2 += NGW) rms_rows2_to_bf16(F.x + (size_t)(2 * m2) * DM, F.norm_w, F.XN + (size_t)(2 * m2) * DM, F.lane);
    { const int gt = F.vcu * (NWAVES * 64) + F.tid, NT = F.G * NWAVES * 64;
      for (int i = gt; i < M * 32; i += NT) { const int m = i >> 5, f = i & 31; const float ang = (float)F.positions[m] * inv_freq_f(f); double c, s; sincos_d((double)ang, c, s); F.cos_t[i] = (float)c; F.sin_t[i] = (float)s; } }
}
__device__ __forceinline__ void p0_deferred(Frame& F, int bi, int nb) {
    for (int it = bi; it < 256; it += nb) p0_ssm_tables(F, it >> 2, it & 3);
    __syncthreads();
    LAS float* scr = (LAS float*)(F.lds + RING_OFF + F.wave * 16640);
    const int gw = bi * NWAVES + F.wave, NGW = nb * NWAVES;
    constexpr int I_GLU = (SW / 64) * (SW / 64), I_OUT = (DM / 64) * (DM / 64);
    for (int it = gw; it < I_GLU + I_OUT; it += NGW) {
        if (it < I_GLU) { p0_transpose_item(F.w_glu, SW, SW, F.Wglu_t, nullptr, scr, it, F.lane); continue; }
        const int r = it - I_GLU, kb = r / (DM / 64); const float* gain = (kb < 16) ? F.anw : (F.snw - 1024); p0_transpose_item(F.w_out, DM, DM, F.Wout_t, gain, scr, r, F.lane);
    }
    __syncthreads();
}
__device__ __forceinline__ float gelu_tanh(float y) { const float u = y * __builtin_fmaf(y * y, 0.044715f, 1.0f); return y * __builtin_amdgcn_rcpf(1.0f + __builtin_amdgcn_exp2f(-2.3022082f * u)); }
namespace att {
typedef short bf16x8 __attribute__((ext_vector_type(8)));
typedef short s16x4 __attribute__((ext_vector_type(4)));
typedef float f32x16 __attribute__((ext_vector_type(16)));
constexpr int KS = 144, VS = 528;
constexpr int L_KT = 0, L_VT = 36864, L_STG = 70656, L_L = L_STG + 8 * 4608, L_END = L_L + 8 * 128;
static_assert(L_END <= RING_BYTES, "attention LDS map");
#define CROW(r, hi) (((r) & 3) + 8 * ((r) >> 2) + 4 * (hi))
__device__ __forceinline__ void unpack8(const v4u w, float* o) {
#pragma unroll
    for (int e = 0; e < 4; ++e) { o[2 * e] = pg8::bf_lo(w[e]); o[2 * e + 1] = pg8::bf_hi(w[e]); }
}
struct Raw { v4u k[4], v[4]; };
__device__ __forceinline__ void attn_load_raw(Frame& F, int b, int nb, int kvh, Raw& R) {
    const int tid = F.tid, lane = F.lane, wave = F.wave, r32 = lane & 31, hi = lane >> 5, m0 = b * SEQ + nb * 128;
    const int hr = wave >> 1, qh = wave & 1, head = kvh * 4 + hr, row = tid >> 1, hf = tid & 1, mk = m0 - 128 + row; const bool ok = (nb > 0) || (row >= 128);
    const v4u z4 = (v4u){0u, 0u, 0u, 0u};
    const GAS v4u* kp = (const GAS v4u*)(F.KB + (size_t)(ok ? mk : m0) * KVW + kvh * HD + 16 * hf); const GAS v4u* vp = (const GAS v4u*)(F.VB + (size_t)(ok ? mk : m0) * KVW + kvh * HD + 32 * hf);
    R.k[0] = kp[0]; R.k[1] = kp[1]; R.k[2] = kp[4]; R.k[3] = kp[5];
#pragma unroll
    for (int c4 = 0; c4 < 4; ++c4) R.v[c4] = vp[c4];
    if (!ok) {
#pragma unroll
        for (int c4 = 0; c4 < 4; ++c4) { R.k[c4] = z4; R.v[c4] = z4; } }
}
__device__ __forceinline__ void attn_unit(Frame& F, int b, int nb, int kvh) {
    const int tid = F.tid, lane = F.lane, wave = F.wave, r32 = lane & 31, hi = lane >> 5;
    const int m0 = b * SEQ + nb * 128;
    LAS unsigned char* L = F.lds + RING_OFF;
    __syncthreads();
    Raw R; attn_load_raw(F, b, nb, kvh, R);
    const int hr = wave >> 1, qh = wave & 1, head = kvh * 4 + hr;
    v4u qraw[2][4];
#pragma unroll
    for (int qt = 0; qt < 2; ++qt) { const GAS v4u* qp = (const GAS v4u*)(F.Q + (size_t)(m0 + 32 * (2 * qh + qt) + r32) * AW + head * HD + 8 * hi);
#pragma unroll
        for (int d0 = 0; d0 < 4; ++d0) qraw[qt][d0] = qp[2 * d0]; }
    {
        const int row = tid >> 1, hf = tid & 1;
        LAS v4u* kd = (LAS v4u*)(L + L_KT + row * KS + 32 * hf);
        kd[0] = R.k[0]; kd[1] = R.k[1]; kd[4] = R.k[2]; kd[5] = R.k[3];
        LAS unsigned short* vd = (LAS unsigned short*)(L + L_VT + (32 * hf) * VS + row * 2);
#pragma unroll
        for (int c4 = 0; c4 < 4; ++c4) { const v4u w = R.v[c4];
#pragma unroll
            for (int e = 0; e < 4; ++e) { vd[((8 * c4 + 2 * e) * VS) / 2] = (unsigned short)(w[e] & 0xffffu); vd[((8 * c4 + 2 * e + 1) * VS) / 2] = (unsigned short)(w[e] >> 16); } }
    }
    bf16x8 qr[2][4];
#pragma unroll
    for (int qt = 0; qt < 2; ++qt)
#pragma unroll
        for (int d0 = 0; d0 < 4; ++d0) qr[qt][d0] = __builtin_bit_cast(bf16x8, qraw[qt][d0]);
    __syncthreads();
    const float snk2 = F.sinks[head] * 1.4426950408889634f;
    LAS float* stg = (LAS float*)(L + L_STG + wave * 4608);
    LAS float* lsc = (LAS float*)(L + L_L + wave * 128);
#pragma unroll
    for (int qt = 0; qt < 2; ++qt) {
        const int a = 2 * qh + qt, qrow0 = 32 * a;
        const size_t em = (size_t)(m0 + qrow0 + (lane >> 1)); const int ecol = (lane & 1) * 16;
        f32x16 p[5];
#pragma unroll
        for (int g = 0; g < 5; ++g) { f32x16 acc = {};
            const LAS unsigned char* kb = L + L_KT + (32 * (a + g) + r32) * KS + 16 * hi;
#pragma unroll
            for (int d0 = 0; d0 < 4; ++d0) { const bf16x8 ka = *(const LAS bf16x8*)(kb + 32 * d0); acc = __builtin_amdgcn_mfma_f32_32x32x16_bf16(ka, qr[qt][d0], acc, 0, 0, 0); }
            p[g] = acc; }
        v4u zz[2][2];
#pragma unroll
        for (int dh = 0; dh < 2; ++dh) { const GAS v4u* zp = (const GAS v4u*)(F.ZA + em * AW + head * HD + 32 * dh + ecol); zz[dh][0] = zp[0]; zz[dh][1] = zp[1]; }
#pragma unroll
        for (int r = 0; r < 16; ++r) { p[0][r] = (nb > 0 && CROW(r, hi) > r32) ? p[0][r] : -1e30f; p[4][r] = (CROW(r, hi) <= r32) ? p[4][r] : -1e30f; }
#pragma unroll
        for (int g = 1; g < 4; ++g) { if (nb == 0 && a + g < 4) {
#pragma unroll
            for (int r = 0; r < 16; ++r) p[g][r] = -1e30f; } }
        float mx = snk2;
#pragma unroll
        for (int g = 0; g < 5; ++g)
#pragma unroll
            for (int r = 0; r < 16; ++r) mx = fmaxf(mx, p[g][r]);
        mx = fmaxf(mx, __shfl_xor(mx, 32));
        float l = 0.f;
#pragma unroll
        for (int g = 0; g < 5; ++g)
#pragma unroll
            for (int r = 0; r < 16; ++r) { const float e = __builtin_amdgcn_exp2f(p[g][r] - mx); p[g][r] = e; l += e; }
        l += __shfl_xor(l, 32); l += __builtin_amdgcn_exp2f(snk2 - mx);
        if (hi == 0) lsc[r32] = __builtin_amdgcn_rcpf(l);
        f32x16 o[2]; o[0] = (f32x16){}; o[1] = (f32x16){};
#pragma unroll
        for (int g = 0; g < 5; ++g)
#pragma unroll
            for (int s = 0; s < 2; ++s) { const f32x16& P = p[g];
                const v4u pw = (v4u){pg8::cvt_pk_bf16(P[8 * s], P[8 * s + 1]), pg8::cvt_pk_bf16(P[8 * s + 2], P[8 * s + 3]), pg8::cvt_pk_bf16(P[8 * s + 4], P[8 * s + 5]), pg8::cvt_pk_bf16(P[8 * s + 6], P[8 * s + 7])};
                const bf16x8 pa = __builtin_bit_cast(bf16x8, pw);
                const int kbase = 32 * (a + g) + 16 * s + 4 * hi;
#pragma unroll
                for (int dh = 0; dh < 2; ++dh) { const LAS unsigned char* vb = L + L_VT + (32 * dh + r32) * VS + kbase * 2;
                    const s16x4 v0 = *(const LAS s16x4*)vb, v1 = *(const LAS s16x4*)(vb + 16);
                    const bf16x8 vf = (bf16x8){v0[0], v0[1], v0[2], v0[3], v1[0], v1[1], v1[2], v1[3]};
                    o[dh] = __builtin_amdgcn_mfma_f32_32x32x16_bf16(pa, vf, o[dh], 0, 0, 0); } }
        LDS_WAIT();
        float rl[16];
#pragma unroll
        for (int r = 0; r < 16; ++r) rl[r] = lsc[CROW(r, hi)];
        float ssq = 0.f;
        const int erow = lane >> 1;
#pragma unroll
        for (int dh = 0; dh < 2; ++dh) {
#pragma unroll
            for (int r = 0; r < 16; ++r) stg[CROW(r, hi) * 36 + r32] = o[dh][r] * rl[r];
            LDS_WAIT();
            float z[16]; unpack8(zz[dh][0], z); unpack8(zz[dh][1], z + 8);
            float ov[16];
#pragma unroll
            for (int c4 = 0; c4 < 4; ++c4) { const f32x4 v = *(const LAS f32x4*)(stg + erow * 36 + ecol + 4 * c4);
#pragma unroll
                for (int e = 0; e < 4; ++e) { const float zv = z[4 * c4 + e]; const float val = v[e] * zv * pg8::sigmoidf_(zv); ov[4 * c4 + e] = val; ssq += val * val; } }
            GAS v4u* op = (GAS v4u*)(F.MG + em * 2048 + head * HD + 32 * dh + ecol);
            op[0] = (v4u){pg8::cvt_pk_bf16(ov[0], ov[1]), pg8::cvt_pk_bf16(ov[2], ov[3]), pg8::cvt_pk_bf16(ov[4], ov[5]), pg8::cvt_pk_bf16(ov[6], ov[7])}; op[1] = (v4u){pg8::cvt_pk_bf16(ov[8], ov[9]), pg8::cvt_pk_bf16(ov[10], ov[11]), pg8::cvt_pk_bf16(ov[12], ov[13]), pg8::cvt_pk_bf16(ov[14], ov[15])};
            LDS_WAIT();
        }
        ssq += __shfl_xor(ssq, 1);
        if ((lane & 1) == 0) F.rsq_a[em * 16 + head] = ssq;
    }
}
__device__ __forceinline__ void attn_phase(Frame& F, int rot = 0) {
    constexpr int NU = BATCH * 32 * NKV;
#pragma unroll 1
    for (int it0 = F.vcu; it0 < NU; it0 += F.G) { const int it = (it0 + rot) & (NU - 1); attn_unit(F, it >> 7, (it >> 2) & 31, it & 3); }
    __syncthreads();
}
#undef CROW
}
namespace ssm {
typedef short bf16x8 __attribute__((ext_vector_type(8)));
typedef float f32x16 __attribute__((ext_vector_type(16)));
typedef float f2 __attribute__((ext_vector_type(2)));
constexpr int L_WIN = 0, L_S = 0, SROW = 528, L_SIN = 67584, SINROW = 272, L_TF = 102400, L_TOT = 136192;
static_assert(L_SIN + 128 * SINROW <= L_TF && L_TF + 33792 <= L_TOT && L_TOT + 4 * 512 <= XP_OFF, "ssm LDS map");
#define CROW(r, hi) (((r) & 3) + 8 * ((r) >> 2) + 4 * (hi))
#define BARRIER() do { asm volatile("s_waitcnt vmcnt(0) lgkmcnt(0)" ::: "memory"); __builtin_amdgcn_s_barrier(); asm volatile("" ::: "memory"); } while (0)
#define LBARRIER() do { asm volatile("s_waitcnt lgkmcnt(0)" ::: "memory"); __builtin_amdgcn_s_barrier(); asm volatile("" ::: "memory"); } while (0)
__device__ __forceinline__ void cmul(float& ar, float& ai, float br, float bi) { const float t = ar * br - ai * bi; ai = ar * bi + ai * br; ar = t; }
__device__ __forceinline__ void ssm_unit(Frame& F, int b, int g) {
    const int tid = F.tid, lane = F.lane, wave = F.wave, r32 = lane & 31, hi = lane >> 5, nt = wave & 3, hw = wave >> 2;
    LAS unsigned char* L = F.lds + RING_OFF;
    const unsigned char* tb = F.ssmt + (size_t)g * SSM_GSTRIDE;
    LBARRIER();
    { const GAS v4u* wlp = (const GAS v4u*)(tb + SSM_OFF_WIN) + (wave * 1024 + lane);
#pragma unroll
      for (int k = 0; k < 16; ++k) __builtin_amdgcn_global_load_lds((const unsigned*)(wlp + k * 64), (LAS unsigned*)(L + L_WIN + (wave * 16 + k) * 1024), 16, 0, 0); }
    bf16x8 bu[32];
    { const GAS v4u* up = (const GAS v4u*)(F.U + ((size_t)(((b * 64 + g) * 4 + nt) * 32)) * 512) + lane;
#pragma unroll
      for (int i = 0; i < 32; ++i) bu[i] = __builtin_bit_cast(bf16x8, up[i * 64]); }
    BARRIER();
    f32x16 sa[2]; sa[0] = (f32x16){}; sa[1] = (f32x16){};
#pragma unroll
    for (int i = 0; i < 32; ++i)
#pragma unroll
        for (int pp = 0; pp < 2; ++pp) { const bf16x8 a = *(const LAS bf16x8*)(L + L_WIN + (((2 * hw + pp) * 32 + i) * 64 + lane) * 16); sa[pp] = __builtin_amdgcn_mfma_f32_32x32x16_bf16(a, bu[i], sa[pp], 0, 0, 0); }
    LBARRIER();
#pragma unroll
    for (int pp = 0; pp < 2; ++pp) { LAS unsigned char* sp = L + L_S + (32 * nt + r32) * SROW + (32 * (2 * hw + pp) + 4 * hi) * 4;
#pragma unroll
        for (int a4 = 0; a4 < 4; ++a4) *(LAS f32x4*)(sp + a4 * 32) = (f32x4){sa[pp][4 * a4], sa[pp][4 * a4 + 1], sa[pp][4 * a4 + 2], sa[pp][4 * a4 + 3]}; }
#pragma unroll
    for (int k = 0; k < 4; ++k) __builtin_amdgcn_global_load_lds((const unsigned*)((const GAS v4u*)(tb + SSM_OFF_T) + (wave * 4 + k) * 64 + lane), (LAS unsigned*)(L + L_TF + (wave * 4 + k) * 1024), 16, 0, 0);
    if (tid < 64) ((LAS v4u*)(L + L_TF + 32768))[tid] = (v4u){0u, 0u, 0u, 0u};
    BARRIER();
    const f2 w32 = *(const GAS f2*)(tb + SSM_OFF_W32 + lane * 8);
    if (wave < 4) { float sr = 0.f, si = 0.f;
#pragma unroll 1
        for (int jb = 0; jb < 4; ++jb) { float lr[8], li[8]; LAS unsigned char* row0 = L + L_S + (32 * wave + 8 * jb) * SROW + lane * 4;
#pragma unroll
            for (int j = 0; j < 8; ++j) { lr[j] = *(const LAS float*)(row0 + j * SROW); li[j] = *(const LAS float*)(row0 + j * SROW + 256); }
#pragma unroll
            for (int j = 0; j < 8; ++j) { *(LAS float*)(row0 + j * SROW) = sr; *(LAS float*)(row0 + j * SROW + 256) = si; const float nr = w32.x * sr - w32.y * si + lr[j]; si = w32.x * si + w32.y * sr + li[j]; sr = nr; } }
        *(LAS f2*)(L + L_TOT + wave * 512 + lane * 8) = (f2){sr, si};
    }
    LBARRIER();
    if (wave < 4) {
        float Wr = w32.x, Wi = w32.y;
#pragma unroll
        for (int q = 0; q < 5; ++q) cmul(Wr, Wi, Wr, Wi);
        float cr = 0.f, ci = 0.f;
        for (int m = 0; m < wave; ++m) { const f2 t = *(const LAS f2*)(L + L_TOT + m * 512 + lane * 8); cmul(cr, ci, Wr, Wi); cr += t.x; ci += t.y; }
#pragma unroll 1
        for (int jb = 0; jb < 4; ++jb) { float lr[8], li[8]; const LAS unsigned char* row0 = L + L_S + (32 * wave + 8 * jb) * SROW + lane * 4; LAS unsigned char* so0 = L + L_SIN + (32 * wave + 8 * jb) * SINROW + lane * 2;
#pragma unroll
            for (int j = 0; j < 8; ++j) { lr[j] = *(const LAS float*)(row0 + j * SROW); li[j] = *(const LAS float*)(row0 + j * SROW + 256); }
#pragma unroll
            for (int j = 0; j < 8; ++j) { *(LAS unsigned short*)(so0 + j * SINROW) = (unsigned short)f2bf(lr[j] + cr); *(LAS unsigned short*)(so0 + j * SINROW + 128) = (unsigned short)f2bf(li[j] + ci); cmul(cr, ci, w32.x, w32.y); } }
    }
    LBARRIER();
    v4u wo[8];
    { const GAS v4u* wp = (const GAS v4u*)(tb + SSM_OFF_WOUT + (size_t)((hw * 4) * 8) * 1024) + lane;
#pragma unroll
      for (int ks = 0; ks < 8; ++ks) wo[ks] = wp[ks * 64]; }
    const LAS unsigned char* sb = L + L_SIN + (32 * nt + r32) * SINROW + 16 * hi;
#pragma unroll 1
    for (int k = 0; k < 8; ++k) { const int rt = hw ? 4 + k : (k < 4 ? k : 8 + k); f32x16 acc = {};
#pragma unroll
        for (int ic = 0; ic < 8; ++ic) { if (4 * ic <= 2 * rt + 1) {
            bf16x8 a[4];
#pragma unroll
            for (int e = 0; e < 4; ++e) { const int dd = 2 * rt - (4 * ic + e) + 1; a[e] = *(const LAS bf16x8*)(L + L_TF + ((dd < 0 ? 32 : dd) * 64 + lane) * 16); }
#pragma unroll
            for (int e = 0; e < 4; ++e) acc = __builtin_amdgcn_mfma_f32_32x32x16_bf16(a[e], bu[4 * ic + e], acc, 0, 0, 0); } }
        const int rn = (k < 7) ? (hw ? 5 + k : (k < 3 ? k + 1 : 9 + k)) : rt; const GAS v4u* wpn = (const GAS v4u*)(tb + SSM_OFF_WOUT + (size_t)(rn * 8) * 1024) + lane;
#pragma unroll
        for (int ks = 0; ks < 8; ++ks) { const bf16x8 s = *(const LAS bf16x8*)(sb + 32 * ks); acc = __builtin_amdgcn_mfma_f32_32x32x16_bf16(__builtin_bit_cast(bf16x8, wo[ks]), s, acc, 0, 0, 0); wo[ks] = wpn[ks * 64]; }
        LAS unsigned char* stg = L + wave * 4608;
#pragma unroll
        for (int a4 = 0; a4 < 4; ++a4) { const unsigned lo = pg8::cvt_pk_bf16(gelu_tanh(acc[4 * a4]), gelu_tanh(acc[4 * a4 + 1])), hi2 = pg8::cvt_pk_bf16(gelu_tanh(acc[4 * a4 + 2]), gelu_tanh(acc[4 * a4 + 3]));
            *(LAS unsigned long long*)(stg + r32 * 144 + ((k & 1) * 2 + (a4 >> 1)) * 32 + (8 * (a4 & 1) + 4 * hi) * 2) = (unsigned long long)lo | ((unsigned long long)hi2 << 32); }
        if (k & 1) { bf16* yp = F.YG + ((size_t)g * M + (size_t)(b * SEQ + 32 * 32 * nt + 2 * (rt - 1))) * 16;
            asm volatile("s_waitcnt lgkmcnt(0)" ::: "memory");
#pragma unroll
            for (int i = 0; i < 4; ++i) { const int n = 8 * i + (lane >> 3), ch = lane & 7; const v4u v = *(const LAS v4u*)(stg + n * 144 + ch * 16); *(GAS v4u*)(yp + (size_t)n * 512 + ch * 8) = v; }
            asm volatile("s_waitcnt lgkmcnt(0)" ::: "memory"); } }
}
__device__ __forceinline__ void ssm_phase(Frame& F, int rot = 0) {
    for (int it0 = F.vcu; it0 < BATCH * SG; it0 += F.G) { const int it = (it0 + rot) & (BATCH * SG - 1); ssm_unit(F, it & 3, it >> 2); }
    LBARRIER();
}
#undef CROW
#undef BARRIER
#undef LBARRIER
}
struct Args { const void* in[20]; float* out; unsigned char* ws; int ph_lo, ph_hi, li, pad; };
__global__ void __launch_bounds__(NWAVES * 64, 2) hymba_fwd(Args args) {
    extern __shared__ __attribute__((aligned(16))) unsigned char lds[];
    Frame F;
    F.lds = (LAS unsigned char*)lds; F.MISC = (volatile LAS unsigned*)(F.lds + MISC_OFF);
    F.tid = threadIdx.x; F.lane = F.tid & 63; F.wave = __builtin_amdgcn_readfirstlane(F.tid >> 6);
    F.G = gridDim.x; { const int bx = blockIdx.x; F.vcu = (F.G % 8 == 0) ? (bx % 8) * (F.G / 8) + bx / 8 : bx; }
    unsigned char* ws = args.ws; F.ctl = (gu32*)(ws + WS_CTL);
    F.x = (const float*)args.in[0]; F.positions = (const int*)args.in[1]; F.norm_w = (const float*)args.in[2]; F.w_in = (const float*)args.in[3];
    F.q_norm_w = (const float*)args.in[4]; F.k_norm_w = (const float*)args.in[5]; F.sinks = (const float*)args.in[6];
    F.a_re = (const float*)args.in[7]; F.a_im = (const float*)args.in[8]; F.log_step = (const float*)args.in[9];
    F.b_re = (const float*)args.in[10]; F.b_im = (const float*)args.in[11]; F.c_re = (const float*)args.in[12]; F.c_im = (const float*)args.in[13];
    F.d_skip = (const float*)args.in[14]; F.w_glu = (const float*)args.in[15]; F.b_glu = (const float*)args.in[16];
    F.anw = (const float*)args.in[17]; F.snw = (const float*)args.in[18]; F.w_out = (const float*)args.in[19]; F.out = args.out;
    F.Win_t = (bf16*)(ws + WS_WIN); F.Wglu_t = (bf16*)(ws + WS_WGLU); F.Wout_t = (bf16*)(ws + WS_WOUT); F.XN = (bf16*)(ws + WS_XN);
    F.Q = (bf16*)(ws + WS_Q); F.KB = (bf16*)(ws + WS_K); F.VB = (bf16*)(ws + WS_V); F.ZA = (bf16*)(ws + WS_ZA); F.U = (bf16*)(ws + WS_U); F.ZS = (bf16*)(ws + WS_ZS);
    F.YG = (bf16*)(ws + WS_YG); F.MG = (bf16*)(ws + WS_MG);
    F.cos_t = (float*)(ws + WS_ROPE); F.sin_t = (float*)(ws + WS_ROPE + 2 * MiB); F.rsq_a = (float*)(ws + WS_RSQA); F.rsq_s = (float*)(ws + WS_RSQS); F.ssmt = ws + WS_SSMT;
    for (int u = F.tid; u < (LDS_BYTES - LDSCTL_OFF) / 4; u += NWAVES * 64) ((LAS unsigned*)(F.lds + LDSCTL_OFF))[u] = 0u;
    __syncthreads();
    XcdBarrier bar; bar.bar = (unsigned*)(F.ctl + CW_BAR); bar.x = 0; bar.st = nullptr;
    if (N_LAUNCHES != PER_PHASE) bar = xcd_barrier_post((unsigned*)(F.ctl + CW_BAR), F.MISC + 8);
#define GRID_BAR(seam) do { if (N_LAUNCHES == PER_PHASE) { if (F.tid == 0) __hip_atomic_store(F.ctl + CW_TMO, 0xBADBA0u | (unsigned)(seam), RLX_AGENT); } else { xcd_barrier(bar); } } while (0)
    const int lo = args.ph_lo, hi = args.ph_hi;
#define IN(k) (lo <= (k) && (k) < hi)
#define BOTH(k) (IN(k) && IN((k) + 1))

    if (IN(0)) { PAD_BEGIN(0); REPS(0) { p0_prologue(F); } PAD_END(0); if (BOTH(0)) GRID_BAR(0); }
    if (IN(1)) {
      PAD_BEGIN(1);
      REPS(1) {
        pg8::Gemm g{F.XN, F.Win_t, M, INW, DM}; pg8::StaticOrder S; S.init(M, INW, F.G, (int)blockIdx.x, WGM_P1);
        pg8::EpiProj E{F.Q, F.KB, F.VB, F.ZA, F.U, F.ZS, F.cos_t, F.sin_t, F.q_norm_w, F.k_norm_w};
        pg8::gemm_phase<pg8::EpiProj, pg8::StaticOrder, true, true>(F.lds + RING_OFF, g, S, E);
      }
      { const int nwg = (M / 256) * (INW / 256), rem = nwg % F.G;
        REPS(10) { if (rem == 0) p0_deferred(F, (int)blockIdx.x, F.G); else if ((int)blockIdx.x >= rem) p0_deferred(F, (int)blockIdx.x - rem, F.G - rem); } }
        PAD_END(1);
        if (BOTH(1)) GRID_BAR(1);
    }
    if (IN(2)) {
        PAD_BEGIN(2);
        REPS(2) {
        PAD_BEGIN(20); REPS(20) { ssm::ssm_phase(F); }
        PAD_END(20); PAD_BEGIN(21);
        if (PROBE_DUP == 22) ssm::ssm_phase(F, 136);
        if (PROBE_DUP == 23) att::attn_phase(F, 136);
        REPS(21) { att::attn_phase(F); }
        PAD_END(21);
        }
        PAD_END(2);
        if (BOTH(2)) GRID_BAR(2); }
    if (IN(3)) {
      PAD_BEGIN(3);
      REPS(3) {
        pg8::Gemm g{F.YG, F.Wglu_t, M, SW, SW, 1}; pg8::StaticOrder S; S.init(M, SW, F.G, (int)blockIdx.x, WGM_P3);
        pg8::EpiGlu E{F.YG, F.ZS, F.b_glu, F.MG, F.rsq_s};
        pg8::gemm_phase<pg8::EpiGlu, pg8::StaticOrder, true, true>(F.lds + RING_OFF, g, S, E);
      }
        PAD_END(3);
        if (BOTH(3)) GRID_BAR(3);
    }
    if (IN(4)) {
      if (P4_SKEW_US > 0) { const unsigned long long t0 = __builtin_amdgcn_s_memrealtime(); const unsigned long long d = (unsigned long long)((F.vcu & 3) * P4_SKEW_US) * 100ull;
          while (__builtin_amdgcn_s_memrealtime() - t0 < d) __builtin_amdgcn_s_sleep(8); }
      REPS(4) {
        pg8::Gemm g{F.MG, F.Wout_t, M, DM, DM}; pg8::StaticOrder S; S.init(M, DM, F.G, (int)blockIdx.x, WGM_P4);
        { typedef float f2 __attribute__((ext_vector_type(2))); LAS f2* tab = (LAS f2*)(F.lds + RING_OFF + TAB_OFF);
          for (int x = F.tid; x < 512; x += NWAVES * 64) { const int ui = x >> 8, r = x & 255; pg8::Unit u;
              if (S.next(ui, u)) { const int row = u.pm * 256 + r; const GAS f32x4* pa = (const GAS f32x4*)(F.rsq_a + (size_t)row * 16); const GAS f32x4* ps = (const GAS f32x4*)(F.rsq_s + (size_t)row * 16);
                  float sa = 0.f, ss = 0.f;
#pragma unroll
                  for (int j = 0; j < 4; ++j) { const f32x4 a = pa[j], s = ps[j]; sa += (a.x + a.y) + (a.z + a.w); ss += (s.x + s.y) + (s.z + s.w); }
                  const float ra = 1.0f / sqrtf(sa * (1.f / AW) + EPS), rs = 1.0f / sqrtf(ss * (1.f / SW) + EPS);
                  tab[x] = (f2){ra / rs, rs}; } }
          __syncthreads(); }
        pg8::EpiOut E{F.x, F.out};
        pg8::gemm_phase<pg8::EpiOut, pg8::StaticOrder, true, true>(F.lds + RING_OFF, g, S, E);
      }
    }
#undef IN
#undef BOTH
}

extern "C" void kernel_launch(void* const* d_in, const int* in_sizes, int n_in, void* d_out, int out_size, void* d_ws, size_t ws_size, hipStream_t stream) {
    static int grid = 0;
    if (grid == 0) {
        if (n_in != 20 || in_sizes[0] != M * DM || out_size != M * DM || ws_size < WS_END) { fprintf(stderr, "kernel_launch: unexpected shapes (n_in %d, in0 %d, out %d, ws %zu); nothing launched\n", n_in, n_in > 0 ? in_sizes[0] : -1, out_size, ws_size); grid = -1; return; }
        int dev = 0, cus = 0, per_cu = 0;
        if (hipGetDevice(&dev) != hipSuccess || hipDeviceGetAttribute(&cus, hipDeviceAttributeMultiprocessorCount, dev) != hipSuccess) { grid = -1; return; }
        if (hipFuncSetAttribute((const void*)hymba_fwd, hipFuncAttributeMaxDynamicSharedMemorySize, LDS_BYTES) != hipSuccess) { fprintf(stderr, "kernel_launch: hipFuncSetAttribute failed\n"); grid = -1; return; }
        if (hipOccupancyMaxActiveBlocksPerMultiprocessor(&per_cu, (const void*)hymba_fwd, NWAVES * 64, LDS_BYTES) != hipSuccess || per_cu < 1) fprintf(stderr, "kernel_launch: occupancy query reports %d workgroups per CU\n", per_cu);
        (void)hipGetLastError();
        grid = cus;
    }
    if (grid < 0) return;
    if (hipMemsetAsync((char*)d_ws + WS_CTL, 0, CTL_ZERO_BYTES, stream) != hipSuccess) { fprintf(stderr, "kernel_launch: hipMemsetAsync failed\n"); return; }
    Args a{};
    for (int i = 0; i < 20; ++i) a.in[i] = d_in[i];
    a.out = (float*)d_out; a.ws = (unsigned char*)d_ws;
    for (int li = 0; li < N_LAUNCHES; ++li) {
        a.ph_lo = (N_LAUNCHES == PER_PHASE) ? li : 0; a.ph_hi = (N_LAUNCHES == PER_PHASE) ? li + 1 : PER_PHASE; a.li = li;
        hipLaunchKernelGGL(hymba_fwd, dim3(grid), dim3(NWAVES * 64), LDS_BYTES, stream, a);
        const hipError_t le = hipPeekAtLastError();
        if (le != hipSuccess) { fprintf(stderr, "kernel_launch: launch %d failed: %s\n", li, hipGetErrorName(le)); break; }
    }
}
```

```cpp
#include <hip/hip_runtime.h>
#include <cstdio>
#include <cstdint>

#ifndef MIX_ROT
#define MIX_ROT 0
#endif
#ifndef PNF_P1
#define PNF_P1 1
#endif
#ifndef PNF_P3
#define PNF_P3 0
#endif
#ifndef PNF_P4
#define PNF_P4 0
#endif
#ifndef WGM_P1
#define WGM_P1 3
#endif
#ifndef WGM_P3
#define WGM_P3 4
#endif
#ifndef WGM_P4
#define WGM_P4 4
#endif
#ifndef P4_SKEW_US
#define P4_SKEW_US 0
#endif
#ifndef PROBE_PAD_PHASE
#define PROBE_PAD_PHASE -1
#endif
#ifndef PROBE_PAD_US
#define PROBE_PAD_US 0
#endif
#define PAD_BEGIN(k) const unsigned long long pad_t0_##k = (PROBE_PAD_PHASE == (k)) ? __builtin_amdgcn_s_memrealtime() : 0ull
#define PAD_END(k) do { if (PROBE_PAD_PHASE == (k)) { while (__builtin_amdgcn_s_memrealtime() - pad_t0_##k < (unsigned long long)(PROBE_PAD_US) * 100ull) __builtin_amdgcn_s_sleep(8); } } while (0)
#ifndef PROBE_DUP
#define PROBE_DUP -1
#endif
#define REPS(k) _Pragma("unroll") for (int rep_ = 0; rep_ < ((PROBE_DUP == (k)) ? 2 : 1); ++rep_)
constexpr int BATCH = 4, SEQ = 4096, DM = 2048, M = BATCH * SEQ;
constexpr int AW = 1024, KVW = 256, SW = 1024, INW = 4608, HD = 64, NH = 16, NKV = 4;
constexpr int SG = 64, SH = 16, SP = 64;
constexpr float EPS = 1e-6f;
constexpr int XP_OFF = 142848, TAB_OFF = 159232;

namespace pg8 {
#define PG8_LAS __attribute__((address_space(3)))
typedef unsigned short bf16_t;
typedef short bf16x8 __attribute__((ext_vector_type(8)));
typedef float f32x4 __attribute__((ext_vector_type(4)));
typedef unsigned u32x4 __attribute__((ext_vector_type(4)));
constexpr int BM = 256, BK = 64, HALF = 128, HTB = HALF * BK * 2  , STAGE_BYTES = 8 * HTB, NXCD = 8, WGM = 8;

__host__ __device__ __forceinline__ int lds_byte(int r, int c) { const int st = (r >> 4) * 2 + (c >> 5), rr = r & 15, cc = c & 31, ob = rr * 64 + cc * 2; return st * 1024 + (ob ^ (((ob >> 9) & 1) << 5)); }
__host__ __device__ __forceinline__ void stage_rc(int b, int& R, int& C) { const int st = b / 1024, sb = b % 1024, swz = sb ^ (((sb >> 9) & 1) << 5); R = (st >> 1) * 16 + swz / 64; C = (st & 1) * 32 + (swz % 64) / 2; }
__host__ __device__ __forceinline__ int perm32(int rho) { const int n = rho >> 4, i = rho & 15; return 8 * (i >> 2) + 4 * n + (i & 3); }

struct Unit { int pm, pn; };
struct Gemm { const bf16_t* A; const bf16_t* Bt; int M, N, K; int ablk = 0; };

struct StaticOrder {
    int nM, nN, nwg, G, c, wgm, pnf;
    __host__ __device__ void init(int M, int N, int G_, int c_, int wgm_ = WGM, int pnf_ = 0) { nM = M / BM; nN = N / BM; nwg = nM * nN; G = G_; c = c_; wgm = wgm_; pnf = pnf_; }
    __host__ __device__ bool next(int i, Unit& u) const {
        const long L = (long)i * G + c; if (L >= nwg) return false;
        int wgid = (int)L; { const int q = nwg / NXCD, r = nwg % NXCD, xcd = wgid % NXCD, off = wgid / NXCD; wgid = (xcd < r ? xcd * (q + 1) : r * (q + 1) + (xcd - r) * q) + off; }
        const int nig = wgm * nN, gid = wgid / nig, fm = gid * wgm, gsz = (nM - fm) < wgm ? (nM - fm) : wgm;
        if (pnf) { u.pm = fm + (wgid % nig) / nN; u.pn = (wgid % nig) % nN; } else { u.pm = fm + ((wgid % nig) % gsz); u.pn = (wgid % nig) / gsz; } return true;
    }
    __device__ __forceinline__ void a_ready(const Unit&) const {}
    __device__ __forceinline__ void done(const Unit&) const {}
};

__device__ __forceinline__ unsigned cvt_pk_bf16(float lo, float hi) { unsigned r; asm volatile("v_cvt_pk_bf16_f32 %0, %1, %2" : "=v"(r) : "v"(lo), "v"(hi)); return r; }
typedef float f32x2 __attribute__((ext_vector_type(2)));
__device__ __forceinline__ float bf_lo(unsigned w) { return __uint_as_float(w << 16); }
__device__ __forceinline__ float bf_hi(unsigned w) { return __uint_as_float(w & 0xffff0000u); }
__device__ __forceinline__ float sigmoidf_(float x) { return __builtin_amdgcn_rcpf(1.0f + __expf(-x)); }

struct EpiProj {
    static constexpr bool PERM = true, AFTER_DRAIN = false, HAS_MID = false;
    bf16_t *Q, *Kb, *Vb, *ZA, *U, *ZS; const float *cos_t, *sin_t, *qnw, *knw;
    __device__ __forceinline__ void mid(f32x4 (&acc)[2][2][4][2], const Unit&, int, int, int, int, int, int, int, PG8_LAS unsigned char*) const {}
    __device__ __forceinline__ void operator()(const f32x4 (&acc)[2][2][4][2], const Unit& u, int ui, int wr, int wc, int fr, int fq, PG8_LAS unsigned char* lds) const {
        const int row0 = u.pm * BM + wr * 64 + fr; const int pn = u.pn;
        if (pn <= 4) {
            const float* nw = pn < 4 ? qnw : knw; bf16_t* base = pn < 4 ? Q + (pn * 4 + wc) * 64 : Kb + wc * 64; const int ldc = pn < 4 ? 1024 : 256;
            const float osc = pn < 4 ? 0.125f * 1.4426950408889634f : 1.0f;
            const f32x4 w1a = *(const f32x4*)(nw + 8 * fq), w1b = *(const f32x4*)(nw + 8 * fq + 4), w2a = *(const f32x4*)(nw + 32 + 8 * fq), w2b = *(const f32x4*)(nw + 32 + 8 * fq + 4);
#pragma unroll
            for (int ai = 0; ai < 2; ++ai)
#pragma unroll
                for (int m = 0; m < 4; ++m) { const int row = row0 + ai * HALF + m * 16;
                    const f32x4 x1a = acc[ai][0][m][0], x1b = acc[ai][0][m][1], x2a = acc[ai][1][m][0], x2b = acc[ai][1][m][1];
                    const f32x4 ca = *(const f32x4*)(cos_t + (size_t)row * 32 + 8 * fq), cb = *(const f32x4*)(cos_t + (size_t)row * 32 + 8 * fq + 4), sa = *(const f32x4*)(sin_t + (size_t)row * 32 + 8 * fq), sb = *(const f32x4*)(sin_t + (size_t)row * 32 + 8 * fq + 4);
                    float ss = 0.f;
#pragma unroll
                    for (int e = 0; e < 4; ++e) ss += x1a[e] * x1a[e] + x1b[e] * x1b[e] + x2a[e] * x2a[e] + x2b[e] * x2b[e];
                    ss += __shfl_xor(ss, 16); ss += __shfl_xor(ss, 32);
                    const float rstd = (1.0f / sqrtf(ss * (1.f / 64.f) + 1e-6f)) * osc;
                    const f32x4 a_a = x1a * rstd * w1a, a_b = x1b * rstd * w1b, b_a = x2a * rstd * w2a, b_b = x2b * rstd * w2b;
                    const f32x4 o1a = a_a * ca - b_a * sa, o1b = a_b * cb - b_b * sb, o2a = b_a * ca + a_a * sa, o2b = b_b * cb + a_b * sb;
                    u32x4 w1, w2; w1.x = cvt_pk_bf16(o1a[0], o1a[1]); w1.y = cvt_pk_bf16(o1a[2], o1a[3]); w1.z = cvt_pk_bf16(o1b[0], o1b[1]); w1.w = cvt_pk_bf16(o1b[2], o1b[3]);
                    w2.x = cvt_pk_bf16(o2a[0], o2a[1]); w2.y = cvt_pk_bf16(o2a[2], o2a[3]); w2.z = cvt_pk_bf16(o2b[0], o2b[1]); w2.w = cvt_pk_bf16(o2b[2], o2b[3]);
                    bf16_t* p = base + (size_t)row * ldc + 8 * fq; *(u32x4*)p = w1; *(u32x4*)(p + 32) = w2; }
            return; }
        bf16_t* base; int ldc, colt; bool isU = false;
        if (pn == 5) { base = Vb; ldc = 256; colt = 0; }
        else if (pn < 10) { base = ZA; ldc = 1024; colt = (pn - 6) * 256; }
        else if (pn < 14) { base = U; ldc = 1024; colt = (pn - 10) * 256; isU = true; }
        else { base = ZS; ldc = 1024; colt = (pn - 14) * 256; }
        const int col0 = colt + wc * 32 + 8 * fq;
#pragma unroll
        for (int ai = 0; ai < 2; ++ai)
#pragma unroll
            for (int m = 0; m < 4; ++m) { const int row = row0 + ai * HALF + m * 16;
#pragma unroll
                for (int bj = 0; bj < 2; ++bj) { const f32x4 v0 = acc[ai][bj][m][0], v1 = acc[ai][bj][m][1]; const int col = col0 + bj * HALF;
                    u32x4 w; w.x = cvt_pk_bf16(v0[0], v0[1]); w.y = cvt_pk_bf16(v0[2], v0[3]); w.z = cvt_pk_bf16(v1[0], v1[1]); w.w = cvt_pk_bf16(v1[2], v1[3]);
                    bf16_t* p;
                    if (isU) { const int b = row >> 12, t = row & 4095, g = col >> 4, hi8 = (col >> 3) & 1; p = base + ((size_t)((((b * 64 + g) * 4 + (t >> 10)) * 32 + (t & 31)) * 64 + hi8 * 32 + ((t >> 5) & 31))) * 8; }
                    else p = base + (size_t)row * ldc + col;
                    *(u32x4*)p = w; } }
    }
};
struct EpiGlu {
    static constexpr bool PERM = true, AFTER_DRAIN = false, HAS_MID = false;
    const bf16_t* YG; const bf16_t* ZS; const float* bias; bf16_t* MG; float* rsq;
    __device__ __forceinline__ void mid(f32x4 (&acc)[2][2][4][2], const Unit&, int, int, int, int, int, int, int, PG8_LAS unsigned char*) const {}
    __device__ __forceinline__ void operator()(const f32x4 (&acc)[2][2][4][2], const Unit& u, int ui, int wr, int wc, int fr, int fq, PG8_LAS unsigned char* lds) const {
        const int row0 = u.pm * BM + wr * 64 + fr; const int col0 = u.pn * BM + wc * 32 + 8 * fq;
        f32x4 bv[2][2];
#pragma unroll
        for (int bj = 0; bj < 2; ++bj)
#pragma unroll
            for (int n = 0; n < 2; ++n) bv[bj][n] = *(const f32x4*)(bias + col0 + bj * HALF + 4 * n);
#pragma unroll
        for (int ai = 0; ai < 2; ++ai)
#pragma unroll
            for (int m = 0; m < 4; ++m) { const int row = row0 + ai * HALF + m * 16; float ss = 0.f;
#pragma unroll
                for (int bj = 0; bj < 2; ++bj) { const int col = col0 + bj * HALF;
                    const u32x4 yv = *(const u32x4*)(YG + ((size_t)(col >> 4) * M + row) * 16 + (col & 15)), zv = *(const u32x4*)(ZS + (size_t)row * 1024 + col);
                    const f32x4 g0 = acc[ai][bj][m][0] + bv[bj][0], g1 = acc[ai][bj][m][1] + bv[bj][1];
                    float o[8];
#pragma unroll
                    for (int e = 0; e < 8; ++e) { const unsigned yw = yv[e >> 1], zw = zv[e >> 1]; const float y = (e & 1) ? bf_hi(yw) : bf_lo(yw), z = (e & 1) ? bf_hi(zw) : bf_lo(zw);
                        const float gt = e < 4 ? g0[e & 3] : g1[e & 3]; o[e] = y * sigmoidf_(gt) * z * sigmoidf_(z); ss += o[e] * o[e]; }
                    u32x4 w; w.x = cvt_pk_bf16(o[0], o[1]); w.y = cvt_pk_bf16(o[2], o[3]); w.z = cvt_pk_bf16(o[4], o[5]); w.w = cvt_pk_bf16(o[6], o[7]);
                    *(u32x4*)(MG + (size_t)row * 2048 + 1024 + col) = w; }
                ss += __shfl_xor(ss, 16); ss += __shfl_xor(ss, 32);
                if (fq == 0) rsq[(size_t)row * 16 + u.pn * 4 + wc] = ss; }
    }
};
struct EpiOut {
    static constexpr bool PERM = false, AFTER_DRAIN = false, HAS_MID = true;
    const float* X; float* OUT;
    template <int E> __device__ __forceinline__ void cons1(f32x4 (&acc)[2][2][4][2], const f32x4 x0, const f32x4 x1, bool first_half, const PG8_LAS f32x2* tab, int wr, int fr) const {
        constexpr int ai = E >> 3, bj = (E >> 2) & 1, m = E & 3; const f32x2 tv = tab[ai * HALF + wr * 64 + m * 16 + fr];
        const float f = __builtin_amdgcn_rcpf(first_half ? tv.x * tv.y : tv.y);
        acc[ai][bj][m][0] = acc[ai][bj][m][0] + x0 * f; acc[ai][bj][m][1] = acc[ai][bj][m][1] + x1 * f;
        asm volatile("" : "+v"(acc[ai][bj][m][0]), "+v"(acc[ai][bj][m][1]));
    }
    __device__ __forceinline__ void consume(f32x4 (&acc)[2][2][4][2], const f32x4 x0, const f32x4 x1, int ec, bool first_half, const PG8_LAS f32x2* tab, int wr, int fr) const {
        switch (ec) {
            case 0: cons1<0>(acc, x0, x1, first_half, tab, wr, fr); break;   case 1: cons1<1>(acc, x0, x1, first_half, tab, wr, fr); break;
            case 2: cons1<2>(acc, x0, x1, first_half, tab, wr, fr); break;   case 3: cons1<3>(acc, x0, x1, first_half, tab, wr, fr); break;
            case 4: cons1<4>(acc, x0, x1, first_half, tab, wr, fr); break;   case 5: cons1<5>(acc, x0, x1, first_half, tab, wr, fr); break;
            case 6: cons1<6>(acc, x0, x1, first_half, tab, wr, fr); break;   case 7: cons1<7>(acc, x0, x1, first_half, tab, wr, fr); break;
            case 8: cons1<8>(acc, x0, x1, first_half, tab, wr, fr); break;   case 9: cons1<9>(acc, x0, x1, first_half, tab, wr, fr); break;
            case 10: cons1<10>(acc, x0, x1, first_half, tab, wr, fr); break; case 11: cons1<11>(acc, x0, x1, first_half, tab, wr, fr); break;
            case 12: cons1<12>(acc, x0, x1, first_half, tab, wr, fr); break; case 13: cons1<13>(acc, x0, x1, first_half, tab, wr, fr); break;
            case 14: cons1<14>(acc, x0, x1, first_half, tab, wr, fr); break; case 15: cons1<15>(acc, x0, x1, first_half, tab, wr, fr); break;
            default: break; }
    }
    __device__ __forceinline__ void mid(f32x4 (&acc)[2][2][4][2], const Unit& u, int ui, int t, int nt, int wr, int wc, int fr, int fq, PG8_LAS unsigned char* lds) const {
        const int h = nt / 2;
        const PG8_LAS f32x2* tab = (const PG8_LAS f32x2*)(lds + TAB_OFF) + ui * 256;
        if (t == h) {
#pragma unroll
            for (int ai = 0; ai < 2; ++ai)
#pragma unroll
                for (int m = 0; m < 4; ++m) { const float ratio = tab[ai * HALF + wr * 64 + m * 16 + fr].x;
#pragma unroll
                    for (int bj = 0; bj < 2; ++bj)
#pragma unroll
                        for (int n = 0; n < 2; ++n) acc[ai][bj][m][n] = acc[ai][bj][m][n] * ratio; } }
        const int ei = (t * 16) / nt;
        { unsigned ln; asm volatile("v_mbcnt_lo_u32_b32 %0, -1, 0\n\tv_mbcnt_hi_u32_b32 %0, -1, %0" : "=v"(ln)); fr = (int)(ln & 15u); fq = (int)(ln >> 4); }
        PG8_LAS unsigned char* slot = lds + XP_OFF + (wr * 4 + wc) * 2048;
        if (ei > 0) { const f32x4 x0 = *(const PG8_LAS f32x4*)(slot + (fr * 4 + fq) * 16), x1 = *(const PG8_LAS f32x4*)(slot + 1024 + (fr * 4 + fq) * 16);
            consume(acc, x0, x1, ei - 1, t < h, tab, wr, fr); }
        { const int ai = ei >> 3, bj = (ei >> 2) & 1, m = ei & 3;
          const char* pu = (const char*)(X + (size_t)(u.pm * BM + ai * HALF + m * 16) * 2048 + u.pn * BM + bj * HALF);
          const int ln_ = fq * 16 + fr;
          const unsigned vo = (unsigned)((wr * 64 + (ln_ >> 2)) * 2048 + wc * 32 + 4 * (ln_ & 3)) * 4u;
          asm volatile("s_waitcnt lgkmcnt(0)" ::: "memory");
          __builtin_amdgcn_global_load_lds((const unsigned*)(pu + vo), (PG8_LAS unsigned*)slot, 16, 0, 0);
          __builtin_amdgcn_global_load_lds((const unsigned*)(pu + vo + 64), (PG8_LAS unsigned*)(slot + 1024), 16, 0, 0); }
    }
    __device__ __forceinline__ void operator()(f32x4 (&acc)[2][2][4][2], const Unit& u, int ui, int wr, int wc, int fr, int fq, PG8_LAS unsigned char* lds) const {
        const PG8_LAS f32x2* tab = (const PG8_LAS f32x2*)(lds + TAB_OFF) + ui * 256;
        { const PG8_LAS unsigned char* slot = lds + XP_OFF + (wr * 4 + wc) * 2048; const f32x4 x0 = *(const PG8_LAS f32x4*)(slot + (fr * 4 + fq) * 16), x1 = *(const PG8_LAS f32x4*)(slot + 1024 + (fr * 4 + fq) * 16);
          cons1<15>(acc, x0, x1, false, tab, wr, fr); }
        const int lane = fq * 16 + fr, rho = lane >> 3, n2 = (lane >> 2) & 1, fq2 = lane & 3;
        const int col0 = u.pn * BM + wc * 32 + 16 * n2 + 4 * fq2;
#pragma unroll
        for (int ai = 0; ai < 2; ++ai)
#pragma unroll
            for (int m = 0; m < 4; ++m) { const int rb = ai * HALF + wr * 64 + m * 16; const float rs = tab[rb + fr].y;
#pragma unroll
                for (int bj = 0; bj < 2; ++bj) { const f32x4 v0 = acc[ai][bj][m][0] * rs, v1 = acc[ai][bj][m][1] * rs;
#pragma unroll
                    for (int k = 0; k < 2; ++k) { const int src4 = ((fq2 << 4) | (8 * k + rho)) << 2; f32x4 w;
#pragma unroll
                        for (int e = 0; e < 4; ++e) { const int a = __builtin_amdgcn_ds_bpermute(src4, __float_as_int(v0[e])), b = __builtin_amdgcn_ds_bpermute(src4, __float_as_int(v1[e])); w[e] = __int_as_float(n2 ? b : a); }
                        *(f32x4*)(OUT + (size_t)(u.pm * BM + rb + 8 * k + rho) * 2048 + col0 + bj * HALF) = w; } } }
    }
};

template <class Epi, class Sched, bool ALIGN_EPI = false, bool SP2 = false>
__device__ __forceinline__ void gemm_phase(PG8_LAS unsigned char* lds, const Gemm g, const Sched& S, const Epi& E) {
    const int tid = threadIdx.x, wid = __builtin_amdgcn_readfirstlane(tid >> 6), lane = tid & 63, wr = wid >> 2, wc = wid & 3, fr = lane & 15, fq = lane >> 4;
    const int K = g.K, nt = K / BK;
    unsigned voffA[2], voffB[2];
#pragma unroll
    for (int i = 0; i < 2; ++i) { int R, C; stage_rc(tid * 16 + i * 8192, R, C); const int Rb = Epi::PERM ? ((R & ~31) + perm32(R & 31)) : R;
        voffA[i] = g.ablk ? (unsigned)(((C >> 4) * g.M + R) * 16 + (C & 15)) * 2u : (unsigned)(R * K + C) * 2u; voffB[i] = (unsigned)(Rb * K + C) * 2u; }
    const size_t kstep = (size_t)(BK * 2);
    const size_t hstep = (size_t)HALF * K * 2;
    const size_t tstep = 2 * hstep;
    const size_t kstepA = g.ablk ? (size_t)4 * g.M * 32 : kstep, hstepA = g.ablk ? (size_t)HALF * 32 : hstep, tstepA = 2 * hstepA;
    const unsigned ldsw = (unsigned)wid * 1024u;
    const int aoff = lds_byte(wr * 64 + fr, fq * 8), boff = lds_byte(wc * 32 + fr, fq * 8);
#define PG8_SA(b, h) (((b) * 2 + (h)) * HTB)
#define PG8_SB(b, h) ((4 + (b) * 2 + (h)) * HTB)
#define PG8_STAGE(bufoff, gbase, voff) do { _Pragma("unroll") for (int _i = 0; _i < 2; ++_i) \
        __builtin_amdgcn_global_load_lds((const unsigned*)((const char*)(gbase) + (voff)[_i]), (PG8_LAS unsigned*)(lds + (bufoff) + ldsw + _i * 8192), 16, 0, 0); } while (0)
#define PG8_LDA(dst, b, h) do { _Pragma("unroll") for (int m = 0; m < 4; ++m) _Pragma("unroll") for (int k = 0; k < 2; ++k) dst[m][k] = *(const PG8_LAS bf16x8*)(lds + PG8_SA(b, h) + aoff + m * 2048 + k * 1024); } while (0)
#define PG8_LDB(dst, b, h) do { _Pragma("unroll") for (int n = 0; n < 2; ++n) _Pragma("unroll") for (int k = 0; k < 2; ++k) dst[n][k] = *(const PG8_LAS bf16x8*)(lds + PG8_SB(b, h) + boff + n * 2048 + k * 1024); } while (0)
#define PG8_MMA(ai, bj, At, Bt) do { __builtin_amdgcn_s_setprio(1); _Pragma("unroll") for (int m = 0; m < 4; ++m) _Pragma("unroll") for (int n = 0; n < 2; ++n) _Pragma("unroll") for (int k = 0; k < 2; ++k) \
        acc[ai][bj][m][n] = __builtin_amdgcn_mfma_f32_16x16x32_bf16(Bt[n][k], At[m][k], acc[ai][bj][m][n], 0, 0, 0); __builtin_amdgcn_s_setprio(0); } while (0)
#define PG8_WAIT_V(n) asm volatile("s_waitcnt vmcnt(" #n ")" ::: "memory")
#define PG8_WAIT_L(n) asm volatile("s_waitcnt lgkmcnt(" #n ")" ::: "memory")
#define PG8_BAR __builtin_amdgcn_s_barrier()
#define PG8_SCHED __builtin_amdgcn_sched_barrier(0)
    Unit cur, nxt; int ui = 0;
    if (!S.next(0, cur)) return;
    f32x4 acc[2][2][4][2];
#pragma unroll
    for (int a = 0; a < 2; ++a)
#pragma unroll
        for (int b = 0; b < 2; ++b)
#pragma unroll
            for (int m = 0; m < 4; ++m)
#pragma unroll
                for (int n = 0; n < 2; ++n) acc[a][b][m][n] = (f32x4){0.f, 0.f, 0.f, 0.f};
    bf16x8 At[4][2], B0[2][2], B1[2][2];
    const char* cA = (const char*)g.A + (size_t)cur.pm * tstepA; const char* cB = (const char*)g.Bt + (size_t)cur.pn * tstep;
    S.a_ready(cur);
    if constexpr (SP2) {
        PG8_STAGE(PG8_SB(0, 0), cB, voffB); PG8_STAGE(PG8_SB(0, 1), cB + hstep, voffB); PG8_STAGE(PG8_SA(0, 0), cA, voffA); PG8_STAGE(PG8_SA(0, 1), cA + hstepA, voffA);
        if (wr == 1) PG8_BAR;
        PG8_WAIT_V(2); PG8_BAR;
        PG8_STAGE(PG8_SB(1, 0), cB + kstep, voffB); PG8_STAGE(PG8_SA(1, 0), cA + kstepA, voffA); PG8_STAGE(PG8_SB(1, 1), cB + hstep + kstep, voffB);
        PG8_WAIT_V(6); PG8_BAR;
    } else {
        PG8_STAGE(PG8_SB(0, 0), cB, voffB); PG8_STAGE(PG8_SA(0, 0), cA, voffA); PG8_STAGE(PG8_SB(0, 1), cB + hstep, voffB); PG8_STAGE(PG8_SA(0, 1), cA + hstepA, voffA);
        if (wr == 1) PG8_BAR;
        PG8_WAIT_V(4); PG8_BAR;
        PG8_STAGE(PG8_SB(1, 0), cB + kstep, voffB); PG8_STAGE(PG8_SA(1, 0), cA + kstepA, voffA); PG8_STAGE(PG8_SB(1, 1), cB + hstep + kstep, voffB);
        PG8_WAIT_V(6); PG8_BAR;
    }
    for (;;) {
        const bool has_next = S.next(ui + 1, nxt);
        const char* nA = has_next ? (const char*)g.A + (size_t)nxt.pm * tstepA : cA; const char* nB = has_next ? (const char*)g.Bt + (size_t)nxt.pn * tstep : cB;
        for (int t = 0; t < nt; t += 2) {
            if constexpr (Epi::HAS_MID) E.mid(acc, cur, ui, t, nt, wr, wc, fr, fq, lds);
            const bool last = (t == nt - 2);
            const char* a1 = cA + (size_t)(t + 1) * kstepA;
            const char* a2 = last ? nA : cA + (size_t)(t + 2) * kstepA; const char* b2 = last ? nB : cB + (size_t)(t + 2) * kstep;
            const char* a3 = a2 + kstepA; const char* b3 = b2 + kstep;
            if (last && has_next) S.a_ready(nxt);
            if constexpr (SP2) {
            PG8_LDB(B0, 0, 0); PG8_LDB(B1, 0, 1); PG8_SCHED; PG8_LDA(At, 0, 0); PG8_STAGE(PG8_SA(1, 1), a1 + hstepA, voffA);
            PG8_WAIT_V(8); PG8_WAIT_L(0); PG8_BAR; PG8_MMA(0, 0, At, B0); PG8_MMA(0, 1, At, B1); PG8_BAR; PG8_SCHED;
            PG8_LDA(At, 0, 1); PG8_STAGE(PG8_SB(0, 0), b2, voffB); PG8_STAGE(PG8_SB(0, 1), b2 + hstep, voffB); PG8_STAGE(PG8_SA(0, 0), a2, voffA);
            PG8_WAIT_V(8); PG8_WAIT_L(0); PG8_BAR; PG8_MMA(1, 0, At, B0); PG8_MMA(1, 1, At, B1); PG8_BAR; PG8_SCHED;
            PG8_LDB(B0, 1, 0); PG8_LDB(B1, 1, 1); PG8_SCHED; PG8_LDA(At, 1, 0); PG8_STAGE(PG8_SA(0, 1), a2 + hstepA, voffA);
            PG8_WAIT_V(8); PG8_WAIT_L(0); PG8_BAR; PG8_MMA(0, 0, At, B0); PG8_MMA(0, 1, At, B1); PG8_BAR; PG8_SCHED;
            PG8_LDA(At, 1, 1); PG8_STAGE(PG8_SB(1, 0), b3, voffB); PG8_STAGE(PG8_SB(1, 1), b3 + hstep, voffB); PG8_STAGE(PG8_SA(1, 0), a3, voffA);
            PG8_WAIT_V(8); PG8_WAIT_L(0); PG8_BAR; PG8_MMA(1, 0, At, B0); PG8_MMA(1, 1, At, B1); PG8_BAR; PG8_SCHED;
            } else {
            PG8_LDB(B0, 0, 0); PG8_SCHED; PG8_LDA(At, 0, 0); PG8_STAGE(PG8_SA(1, 1), a1 + hstepA, voffA);
            PG8_WAIT_L(8); PG8_BAR; PG8_WAIT_L(0); PG8_MMA(0, 0, At, B0); PG8_BAR; PG8_SCHED;
            PG8_LDB(B1, 0, 1); PG8_STAGE(PG8_SB(0, 0), b2, voffB);
            PG8_BAR; PG8_WAIT_L(0); PG8_MMA(0, 1, At, B1); PG8_BAR;
            PG8_LDA(At, 0, 1); PG8_STAGE(PG8_SA(0, 0), a2, voffA);
            PG8_BAR; PG8_WAIT_L(0); PG8_MMA(1, 0, At, B0); PG8_BAR; PG8_SCHED;
            PG8_STAGE(PG8_SB(0, 1), b2 + hstep, voffB);
            PG8_WAIT_V(6); PG8_BAR; PG8_MMA(1, 1, At, B1); PG8_BAR;
            PG8_LDB(B0, 1, 0); PG8_SCHED; PG8_LDA(At, 1, 0); PG8_STAGE(PG8_SA(0, 1), a2 + hstepA, voffA);
            PG8_WAIT_L(8); PG8_BAR; PG8_WAIT_L(0); PG8_MMA(0, 0, At, B0); PG8_BAR; PG8_SCHED;
            PG8_LDB(B1, 1, 1); PG8_STAGE(PG8_SB(1, 0), b3, voffB);
            PG8_BAR; PG8_WAIT_L(0); PG8_MMA(0, 1, At, B1); PG8_BAR;
            PG8_LDA(At, 1, 1); PG8_STAGE(PG8_SA(1, 0), a3, voffA);
            PG8_BAR; PG8_WAIT_L(0); PG8_MMA(1, 0, At, B0); PG8_BAR; PG8_SCHED;
            PG8_STAGE(PG8_SB(1, 1), b3 + hstep, voffB);
            PG8_WAIT_V(6); PG8_BAR; PG8_MMA(1, 1, At, B1); PG8_BAR;
            }
        }
        if constexpr (ALIGN_EPI) { if (wr == 0) PG8_BAR; }
        E(acc, cur, ui, wr, wc, fr, fq, lds); S.done(cur);
        if (!has_next) break;
#pragma unroll
        for (int a = 0; a < 2; ++a)
#pragma unroll
            for (int b = 0; b < 2; ++b)
#pragma unroll
                for (int m = 0; m < 4; ++m)
#pragma unroll
                    for (int n = 0; n < 2; ++n) acc[a][b][m][n] = (f32x4){0.f, 0.f, 0.f, 0.f};
        cur = nxt; cA = nA; cB = nB; ++ui;
        if constexpr (ALIGN_EPI) { if (wr == 1) PG8_BAR; }
    }
    PG8_WAIT_V(0);
    if constexpr (!ALIGN_EPI) { if (wr == 0) PG8_BAR; }
    PG8_BAR;

#undef PG8_SA
#undef PG8_SB
#undef PG8_STAGE
#undef PG8_LDA
#undef PG8_LDB
#undef PG8_MMA
#undef PG8_WAIT_V
#undef PG8_WAIT_L
#undef PG8_BAR
#undef PG8_SCHED
}
}
constexpr int NWAVES = 8;
#ifndef MK_N_LAUNCHES
#define MK_N_LAUNCHES 1
#endif
constexpr int N_LAUNCHES = MK_N_LAUNCHES;
constexpr int PER_PHASE = 5;

constexpr size_t MiB = 1u << 20;
constexpr size_t WS_CTL = 0, CTL_ZERO_BYTES = 1 * MiB;
constexpr size_t WS_WIN = 2 * MiB, WS_WGLU = 20 * MiB, WS_WOUT = 22 * MiB;
constexpr size_t WS_ROPE = 30 * MiB;
constexpr size_t WS_RSQA = 34 * MiB, WS_RSQS = 35 * MiB;
constexpr size_t WS_SSMT = 36 * MiB, SSM_GSTRIDE = 327680;
constexpr size_t SSM_OFF_T = 0, SSM_OFF_WIN = 36864, SSM_OFF_WOUT = 167936, SSM_OFF_W32 = 299008;
constexpr size_t WS_XN = 64 * MiB;
constexpr size_t WS_Q = 128 * MiB, WS_K = 160 * MiB, WS_V = 168 * MiB, WS_ZA = 176 * MiB, WS_U = 208 * MiB, WS_ZS = 240 * MiB;
constexpr size_t WS_YG = 272 * MiB, WS_MG = 304 * MiB, WS_END = 368 * MiB;
static_assert(WS_SSMT + 64 * SSM_GSTRIDE <= WS_XN, "d_ws map");
constexpr int CW_TMO = 0, CW_CODE = 1, CW_BAR = 4096;

constexpr int RING_OFF = 0, RING_BYTES = 131072;
constexpr int LDSCTL_OFF = 163328, MISC_OFF = LDSCTL_OFF + 320;
constexpr int LDS_BYTES = 163840;

#define GAS __attribute__((address_space(1)))
#define LAS __attribute__((address_space(3)))
typedef unsigned short bf16;
typedef unsigned v4u __attribute__((ext_vector_type(4)));
typedef float f32x4 __attribute__((ext_vector_type(4)));
typedef short bf16x8 __attribute__((ext_vector_type(8)));
typedef GAS unsigned gu32;
typedef GAS unsigned long long gu64;
#define RLX_AGENT __ATOMIC_RELAXED, __HIP_MEMORY_SCOPE_AGENT
#define LDS_WAIT() asm volatile("s_waitcnt lgkmcnt(0)" ::: "memory")
#define VM_WAIT() asm volatile("s_waitcnt vmcnt(0)" ::: "memory")
__device__ __forceinline__ unsigned long long rt() { return __builtin_amdgcn_s_memrealtime(); }
__device__ __forceinline__ unsigned f2bf(float f) { unsigned u = __builtin_bit_cast(unsigned, f); return (u + 0x7fffu + ((u >> 16) & 1u)) >> 16; }
__device__ __forceinline__ unsigned pk2(float lo, float hi) { return f2bf(lo) | (f2bf(hi) << 16); }

#define XB_TMO      128
#define XB_XCNT(j)  (256  + 64 * (j))
#define XB_XSUB(j)  (1280 + 64 * (j))
#define XB_XGEN(j)  (2304 + 64 * (j))
#define XB_TOP      3328
#define XB_TOPGEN   3392
#define XCD_BAR_WORDS 3456
#define XB_SPIN_CAP (1u << 18)

__device__ __forceinline__ unsigned xb_ld(unsigned* p)              { return __hip_atomic_load(p, __ATOMIC_RELAXED, __HIP_MEMORY_SCOPE_AGENT); }
__device__ __forceinline__ unsigned xb_add(unsigned* p, unsigned v) { return __hip_atomic_fetch_add(p, v, __ATOMIC_RELAXED, __HIP_MEMORY_SCOPE_AGENT); }
__device__ __forceinline__ unsigned xb_xcc_id() { return (unsigned)__builtin_amdgcn_s_getreg((3 << 11) | 20) & 0xFu; }
#define XB_SPIN(cond, bar) do { unsigned _sp = 0; while (cond) { __builtin_amdgcn_s_sleep(16); \
    if ((++_sp & 255u) == 0u) { if (xb_ld(&(bar)[XB_TMO])) break; if (_sp > XB_SPIN_CAP) { atomicAdd(&(bar)[XB_TMO], 1u); break; } } } } while (0)

struct XcdBarrier {
    unsigned* bar; unsigned x;
    volatile LAS unsigned* st;
};

__device__ __forceinline__ XcdBarrier xcd_barrier_post(unsigned* bar, volatile LAS unsigned* st) {
    XcdBarrier b; b.bar = bar; b.x = xb_xcc_id(); b.st = st;
    if (threadIdx.x == 0) (void)xb_add(&bar[XB_XCNT(b.x)], 1u);
    return b;
}
__device__ __forceinline__ void xcd_barrier_complete(unsigned* bar, unsigned x, unsigned& nloc, unsigned& nx) {
    const unsigned G = gridDim.x * gridDim.y * gridDim.z;
    unsigned sum, cnt, mine, sp = 0u;
    for (;;) {
        sum = 0u; cnt = 0u; mine = 0u;
#pragma unroll
        for (unsigned j = 0; j < 16; ++j) { const unsigned c = xb_ld(&bar[XB_XCNT(j)]); sum += c; cnt += (c > 0u) ? 1u : 0u; mine = (j == x) ? c : mine; }
        if (sum == G) break;
        __builtin_amdgcn_s_sleep(1);
        if ((++sp & 255u) == 0u) { if (xb_ld(&bar[XB_TMO])) break; if (sp > XB_SPIN_CAP) { atomicAdd(&bar[XB_TMO], 1u); break; } }
    }
    nloc = mine > 0u ? mine : 1u; nx = cnt > 0u ? cnt : 1u;
}

__device__ __forceinline__ void xcd_barrier(const XcdBarrier& b) {
    asm volatile("s_waitcnt vmcnt(0)" ::: "memory");
    __syncthreads();
    if (threadIdx.x == 0) {
        unsigned* bar = b.bar;
        __builtin_amdgcn_s_waitcnt(0);
        unsigned nloc = b.st[0], nx = b.st[1];
        if (nloc == 0u) { xcd_barrier_complete(bar, b.x, nloc, nx); b.st[0] = nloc; b.st[1] = nx; }
        const unsigned old = xb_add(&bar[XB_XSUB(b.x)], 1u);
        const unsigned gen = old / nloc;
        if (old + 1u == (gen + 1u) * nloc) {
            __builtin_amdgcn_fence(__ATOMIC_RELEASE, "agent");
            asm volatile("s_waitcnt vmcnt(0)" ::: "memory");
            const unsigned og = xb_add(&bar[XB_TOP], 1u);
            const unsigned tg = og / nx;
            if (og + 1u == (tg + 1u) * nx) xb_add(&bar[XB_TOPGEN], 1u);
            else XB_SPIN(xb_ld(&bar[XB_TOPGEN]) == tg, bar);
            __builtin_amdgcn_fence(__ATOMIC_ACQUIRE, "agent");
            xb_add(&bar[XB_XGEN(b.x)], 1u);
            asm volatile("s_waitcnt vmcnt(0)" ::: "memory");
        } else {
            XB_SPIN(xb_ld(&bar[XB_XGEN(b.x)]) == gen, bar);
            __builtin_amdgcn_fence(__ATOMIC_ACQUIRE, "agent");
            asm volatile("s_waitcnt vmcnt(0)" ::: "memory");
        }
    }
    __syncthreads();
}
struct Frame {
    LAS unsigned char* lds; volatile LAS unsigned* MISC; gu32* ctl;
    int tid, lane, wave, vcu, G;
    const float *x, *norm_w, *w_in, *q_norm_w, *k_norm_w, *sinks, *a_re, *a_im, *log_step, *b_re, *b_im, *c_re, *c_im, *d_skip, *w_glu, *b_glu, *anw, *snw, *w_out;
    const int* positions; float* out;
    bf16 *Win_t, *Wglu_t, *Wout_t, *XN, *Q, *KB, *VB, *ZA, *U, *ZS, *YG, *MG;
    float *cos_t, *sin_t, *rsq_a, *rsq_s; unsigned char* ssmt;
};
__device__ __forceinline__ float wave_sum(float v) {
#pragma unroll
    for (int o = 1; o < 64; o <<= 1) v += __shfl_xor(v, o);
    return v;
}
__device__ __forceinline__ float wave_max(float v) {
#pragma unroll
    for (int o = 1; o < 64; o <<= 1) v = fmaxf(v, __shfl_xor(v, o));
    return v;
}
__device__ __forceinline__ float bf2f(bf16 v) { return __uint_as_float((unsigned)v << 16); }
__device__ __forceinline__ double exp_d(double x) {
    const double k = rint(x * 1.4426950408889634); const double r = (x - k * 6.93147180369123816490e-01) - k * 1.90821492927058770002e-10;
    double p = 1.0 / 6227020800.0;
    p = p * r + 1.0 / 479001600.0; p = p * r + 1.0 / 39916800.0; p = p * r + 1.0 / 3628800.0; p = p * r + 1.0 / 362880.0; p = p * r + 1.0 / 40320.0; p = p * r + 1.0 / 5040.0;
    p = p * r + 1.0 / 720.0; p = p * r + 1.0 / 120.0; p = p * r + 1.0 / 24.0; p = p * r + 1.0 / 6.0; p = p * r + 0.5; p = p * r + 1.0; p = p * r + 1.0;
    return __builtin_ldexp(p, (int)k);
}
__device__ __forceinline__ void sincos_d(double x, double& c, double& s) {
    const double k = rint(x * 0.63661977236758134308); const double r = (x - k * 1.57079632673412561417e+00) - k * 6.07710050650619224932e-11; const double r2 = r * r;
    double ps = -1.0 / 6227020800.0; ps = ps * r2 + 1.0 / 39916800.0; ps = ps * r2 - 1.0 / 362880.0; ps = ps * r2 + 1.0 / 5040.0; ps = ps * r2 - 1.0 / 120.0; ps = ps * r2 + 1.0 / 6.0; ps = r - r * r2 * ps;
    double pc = 1.0 / 87178291200.0; pc = pc * r2 - 1.0 / 479001600.0; pc = pc * r2 + 1.0 / 3628800.0; pc = pc * r2 - 1.0 / 40320.0; pc = pc * r2 + 1.0 / 720.0; pc = pc * r2 - 1.0 / 24.0; pc = pc * r2 + 0.5; pc = 1.0 - r2 * pc;
    const int q = (int)((long long)k & 3);
    c = (q == 0) ? pc : (q == 1) ? -ps : (q == 2) ? -pc : ps;
    s = (q == 0) ? ps : (q == 1) ? pc : (q == 2) ? -ps : -pc;
}
__device__ __forceinline__ float inv_freq_f(int f) { return (float)exp_d(-(double)f * (9.210340371976184 / 32.0)); }

template <bool QKPERM = false> __device__ __forceinline__ void p0_transpose_item(const float* W, int K, int N, bf16* WT, const float* kscale, LAS float* scr, int item, int lane) {
    const int nblk = N / 64, kb = item / nblk, nb = item % nblk, k0 = 64 * kb, n0 = 64 * nb;
    const int lr = lane >> 4, lc = 4 * (lane & 15);
    f32x4 v[16];
#pragma unroll
    for (int i = 0; i < 16; ++i) v[i] = __builtin_nontemporal_load((const GAS f32x4*)(W + (size_t)(k0 + 4 * i + lr) * N + n0 + lc));
#pragma unroll
    for (int i = 0; i < 16; ++i) { const int kk = 4 * i + lr; f32x4 t = v[i]; if (kscale) t = t * kscale[k0 + kk]; LAS float* d = scr + kk * 65 + lc; d[0] = t.x; d[1] = t.y; d[2] = t.z; d[3] = t.w; }
    LDS_WAIT(); asm volatile("" ::: "memory");
    const int c = lane & 7;
#pragma unroll
    for (int j = 0; j < 8; ++j) { const int n = (lane >> 3) + 8 * j; const LAS float* s = scr + (8 * c) * 65 + n;
        v4u o; o.x = pk2(s[0 * 65], s[1 * 65]); o.y = pk2(s[2 * 65], s[3 * 65]); o.z = pk2(s[4 * 65], s[5 * 65]); o.w = pk2(s[6 * 65], s[7 * 65]);
        int nrow = n0 + n;
        if (QKPERM && nrow < AW + KVW) { const int tile = nrow & ~255, hh = (nrow >> 6) & 3, d = nrow & 63; nrow = tile + 128 * (d >> 5) + 32 * hh + (d & 31); }
        *(GAS v4u*)(WT + (size_t)nrow * K + k0 + 8 * c) = o; }
    LDS_WAIT(); asm volatile("" ::: "memory");
}
__device__ __forceinline__ void rms_rows2_to_bf16(const float* xrow, const float* nw, bf16* orow, int lane) {
    const GAS f32x4* xr = (const GAS f32x4*)xrow + lane; const GAS f32x4* wr = (const GAS f32x4*)nw + lane;
    f32x4 v[2][8]; float s[2] = {0.f, 0.f};
#pragma unroll
    for (int r = 0; r < 2; ++r)
#pragma unroll
        for (int j = 0; j < 8; ++j) v[r][j] = __builtin_nontemporal_load(xr + r * (DM / 4) + 64 * j);
#pragma unroll
    for (int r = 0; r < 2; ++r)
#pragma unroll
        for (int j = 0; j < 8; ++j) s[r] += (v[r][j].x * v[r][j].x + v[r][j].y * v[r][j].y) + (v[r][j].z * v[r][j].z + v[r][j].w * v[r][j].w);
    const float rstd0 = 1.0f / sqrtf(wave_sum(s[0]) * (1.f / DM) + EPS), rstd1 = 1.0f / sqrtf(wave_sum(s[1]) * (1.f / DM) + EPS);
    GAS unsigned long long* o8 = (GAS unsigned long long*)orow + lane;
#pragma unroll
    for (int j = 0; j < 8; ++j) { const f32x4 w = wr[64 * j]; const f32x4 a = v[0][j] * rstd0 * w, b = v[1][j] * rstd1 * w;
        o8[64 * j] = (unsigned long long)pk2(a.x, a.y) | ((unsigned long long)pk2(a.z, a.w) << 32);
        o8[(DM / 4) + 64 * j] = (unsigned long long)pk2(b.x, b.y) | ((unsigned long long)pk2(b.z, b.w) << 32); }
}
__device__ __forceinline__ void p0_ssm_tables(Frame& F, int g, int q) {
    typedef float f2 __attribute__((ext_vector_type(2)));
    LAS f2* pw = (LAS f2*)(F.lds + RING_OFF);
    LAS f2* bb = (LAS f2*)(F.lds + RING_OFF + 17408);
    LAS f2* cc = (LAS f2*)(F.lds + RING_OFF + 25600);
    const int tid = F.tid;
    __syncthreads();
    if (tid < 64) { const int p = tid;
        const double dl = exp_d((double)F.log_step[g]); const double ar = (double)F.a_re[g * 64 + p], ai = (double)F.a_im[g * 64 + p];
        const double mag = exp_d(ar * dl); double c, s; sincos_d(ai * dl, c, s); const double wr = mag * c, wi = mag * s;
        const double nr = wr - 1.0, ni = wi, den = ar * ar + ai * ai; const double cr = (nr * ar + ni * ai) / den, ci = (ni * ar - nr * ai) / den;
#pragma unroll
        for (int h = 0; h < 16; ++h) { const double br = (double)F.b_re[(g * 64 + p) * 16 + h], bi = (double)F.b_im[(g * 64 + p) * 16 + h]; bb[p * 16 + h] = (f2){(float)(cr * br - ci * bi), (float)(cr * bi + ci * br)}; }
        double pr = 1.0, pi = 0.0;
        for (int e = 0; e <= 32; ++e) { pw[e * 64 + p] = (f2){(float)pr, (float)pi}; const double n2 = pr * wr - pi * wi; pi = pr * wi + pi * wr; pr = n2; }
    }
    for (int i = tid; i < 1024; i += NWAVES * 64) { const int h = i >> 6, p = i & 63; cc[p * 16 + h] = (f2){F.c_re[g * 1024 + i], F.c_im[g * 1024 + i]}; }
    __syncthreads();
    unsigned char* base = F.ssmt + (size_t)g * SSM_GSTRIDE;
    {
        const int x = 512 * q + tid, dd = x >> 6, ln = x & 63, r32 = ln & 31, hi = ln >> 5, jj = r32 >> 4, h = r32 & 15, d = dd - 1 + jj;
        float v[8];
#pragma unroll
        for (int e = 0; e < 8; ++e) v[e] = 0.f;
        if (d >= 0 && d <= 31) {
#pragma unroll 4
            for (int p = 0; p < 64; ++p) { const f2 c = cc[p * 16 + h], w = pw[d * 64 + p]; const float mr = c.x * w.x - c.y * w.y, mi = c.x * w.y + c.y * w.x;
#pragma unroll
                for (int e = 0; e < 8; ++e) { const f2 b = bb[p * 16 + 8 * hi + e]; v[e] += mr * b.x - mi * b.y; } }
            if (d == 0) {
#pragma unroll
                for (int e = 0; e < 8; ++e) if (8 * hi + e == h) v[e] += F.d_skip[g * 16 + h]; }
        }
        v4u o; o.x = pk2(v[0], v[1]); o.y = pk2(v[2], v[3]); o.z = pk2(v[4], v[5]); o.w = pk2(v[6], v[7]);
        *(GAS v4u*)(base + SSM_OFF_T + (size_t)(dd * 64 + ln) * 16) = o; }
    for (int x = 2048 * q + tid; x < 2048 * (q + 1); x += NWAVES * 64) { const int ln = x & 63, i = (x >> 6) & 31, pt = x >> 11, r32 = ln & 31, hi = ln >> 5, pc = 32 * pt + r32, p = pc & 63, im = pc >> 6;
        const f2 w = pw[(31 - i) * 64 + p]; float v[8];
#pragma unroll
        for (int e = 0; e < 8; ++e) { const f2 b = bb[p * 16 + 8 * hi + e]; v[e] = im ? (w.x * b.y + w.y * b.x) : (w.x * b.x - w.y * b.y); }
        v4u o; o.x = pk2(v[0], v[1]); o.y = pk2(v[2], v[3]); o.z = pk2(v[4], v[5]); o.w = pk2(v[6], v[7]);
        *(GAS v4u*)(base + SSM_OFF_WIN + (size_t)((pt * 32 + i) * 64 + ln) * 16) = o; }
    for (int x = 2048 * q + tid; x < 2048 * (q + 1); x += NWAVES * 64) { const int ln = x & 63, ks = (x >> 6) & 7, rt = x >> 9, r32 = ln & 31, hi = ln >> 5, jj = r32 >> 4, h = r32 & 15, j = 2 * rt + jj;
        float v[8];
#pragma unroll
        for (int e = 0; e < 8; ++e) { const int pc = 16 * ks + 8 * hi + e, p = pc & 63, im = pc >> 6; const f2 c = cc[p * 16 + h], w = pw[(j + 1) * 64 + p];
            const float mr = c.x * w.x - c.y * w.y, mi = c.x * w.y + c.y * w.x; v[e] = im ? -mi : mr; }
        v4u o; o.x = pk2(v[0], v[1]); o.y = pk2(v[2], v[3]); o.z = pk2(v[4], v[5]); o.w = pk2(v[6], v[7]);
        *(GAS v4u*)(base + SSM_OFF_WOUT + (size_t)((rt * 8 + ks) * 64 + ln) * 16) = o; }
    if (q == 3 && tid < 64) *(GAS f2*)(base + SSM_OFF_W32 + tid * 8) = pw[32 * 64 + tid];
}
__device__ __forceinline__ void p0_prologue(Frame& F) {
    LAS float* scr = (LAS float*)(F.lds + RING_OFF + F.wave * 16640);
    const int gw = F.vcu * NWAVES + F.wave, NGW = F.G * NWAVES;
    constexpr int I_IN = (DM / 64) * (INW / 64);
    PAD_BEGIN(5);
    for (int it = gw; it < I_IN; it += NGW) p0_transpose_item<true>(F.w_in, DM, INW, F.Win_t, nullptr, scr, it, F.lane);
    PAD_END(5);
    if (F.G == 256) {
        const int xg = F.vcu >> 5, wx = (F.vcu & 31) * NWAVES + F.wave;
        for (int k = 0; k < 4; ++k) { const int m2 = 1024 * xg + wx + 256 * k; rms_rows2_to_bf16(F.x + (size_t)(2 * m2) * DM, F.norm_w, F.XN + (size_t)(2 * m2) * DM, F.lane); }
    } else for (int m2 = gw; m2 < M / 2; m2 += NGW) rms_rows2_to_bf16(F.x + (size_t)(2 * m2) * DM, F.norm_w, F.XN + (size_t)(2 * m2) * DM, F.lane);
    { const int gt = F.vcu * (NWAVES * 64) + F.tid, NT = F.G * NWAVES * 64;
      for (int i = gt; i < M * 32; i += NT) { const int m = i >> 5, f = i & 31; const float ang = (float)F.positions[m] * inv_freq_f(f); double c, s; sincos_d((double)ang, c, s); F.cos_t[i] = (float)c; F.sin_t[i] = (float)s; } }
}
__device__ __forceinline__ void p0_deferred(Frame& F, int bi, int nb) {
    for (int it = bi; it < 256; it += nb) p0_ssm_tables(F, it >> 2, it & 3);
    __syncthreads();
    LAS float* scr = (LAS float*)(F.lds + RING_OFF + F.wave * 16640);
    const int gw = bi * NWAVES + F.wave, NGW = nb * NWAVES;
    constexpr int I_GLU = (SW / 64) * (SW / 64), I_OUT = (DM / 64) * (DM / 64);
    for (int it = gw; it < I_GLU + I_OUT; it += NGW) {
        if (it < I_GLU) { p0_transpose_item(F.w_glu, SW, SW, F.Wglu_t, nullptr, scr, it, F.lane); continue; }
        const int r = it - I_GLU, kb = r / (DM / 64); const float* gain = (kb < 16) ? F.anw : (F.snw - 1024); p0_transpose_item(F.w_out, DM, DM, F.Wout_t, gain, scr, r, F.lane);
    }
    __syncthreads();
}
__device__ __forceinline__ float gelu_tanh(float y) { const float u = y * __builtin_fmaf(y * y, 0.044715f, 1.0f); return y * __builtin_amdgcn_rcpf(1.0f + __builtin_amdgcn_exp2f(-2.3022082f * u)); }
namespace att {
typedef short bf16x8 __attribute__((ext_vector_type(8)));
typedef short s16x4 __attribute__((ext_vector_type(4)));
typedef short v4i16_t __attribute__((ext_vector_type(4)));
typedef float f32x16 __attribute__((ext_vector_type(16)));
constexpr int L_KT = 0, L_V = 32768, L_STG = 65536, L_L = L_STG + 8 * 4608, L_END = L_L + 8 * 128;
static_assert(L_END <= RING_BYTES, "attention LDS map");
#define CROW(r, hi) (((r) & 3) + 8 * ((r) >> 2) + 4 * (hi))
__device__ __forceinline__ void unpack8(const v4u w, float* o) {
#pragma unroll
    for (int e = 0; e < 4; ++e) { o[2 * e] = pg8::bf_lo(w[e]); o[2 * e + 1] = pg8::bf_hi(w[e]); }
}
__device__ __forceinline__ void attn_unit(Frame& F, int b, int nb, int kvh) {
    const int tid = F.tid, lane = F.lane, wave = F.wave, r32 = lane & 31, hi = lane >> 5;
    const int m0 = b * SEQ + nb * 128;
    LAS unsigned char* L = F.lds + RING_OFF;
    __syncthreads();
    const int hr = wave >> 1, qh = wave & 1, head = kvh * 4 + hr;
    v4u qraw[2][4];
#pragma unroll
    for (int qt = 0; qt < 2; ++qt) { const GAS v4u* qp = (const GAS v4u*)(F.Q + (size_t)(m0 + 32 * (2 * qh + qt) + r32) * AW + head * HD + 8 * hi);
#pragma unroll
        for (int d0 = 0; d0 < 4; ++d0) qraw[qt][d0] = qp[2 * d0]; }
    {
        const int q0 = (nb > 0) ? 0 : 16;
#pragma unroll
        for (int k = 0; k < 4; ++k) { const int q = 4 * wave + k;
            if (q >= q0) { const size_t src = (size_t)(m0 - 128 + 8 * q + (lane >> 3)) * KVW + kvh * HD + 8 * ((lane & 7) ^ (lane >> 3));
                __builtin_amdgcn_global_load_lds((const unsigned*)(F.KB + src), (LAS unsigned*)(L + L_KT + q * 1024), 16, 0, 0);
                __builtin_amdgcn_global_load_lds((const unsigned*)(F.VB + src), (LAS unsigned*)(L + L_V + q * 1024), 16, 0, 0); } }
        if (nb == 0) { LAS v4u* vz = (LAS v4u*)(L + L_V) + tid; vz[0] = (v4u){0u, 0u, 0u, 0u}; vz[512] = (v4u){0u, 0u, 0u, 0u}; }
    }
    bf16x8 qr[2][4];
#pragma unroll
    for (int qt = 0; qt < 2; ++qt)
#pragma unroll
        for (int d0 = 0; d0 < 4; ++d0) qr[qt][d0] = __builtin_bit_cast(bf16x8, qraw[qt][d0]);
    asm volatile("s_waitcnt vmcnt(0)" ::: "memory");
    __syncthreads();
    const float snk2 = F.sinks[head] * 1.4426950408889634f;
    LAS float* stg = (LAS float*)(L + L_STG + wave * 4608);
    LAS float* lsc = (LAS float*)(L + L_L + wave * 128);
#pragma unroll
    for (int qt = 0; qt < 2; ++qt) {
        const int a = 2 * qh + qt, qrow0 = 32 * a;
        const size_t em = (size_t)(m0 + qrow0 + (lane >> 1)); const int ecol = (lane & 1) * 16;
        f32x16 p[5];
#pragma unroll
        for (int g = 0; g < 5; ++g) { f32x16 acc = {};
            const LAS unsigned char* kb = L + L_KT + (32 * (a + g) + r32) * 128;
#pragma unroll
            for (int d0 = 0; d0 < 4; ++d0) { const bf16x8 ka = *(const LAS bf16x8*)(kb + 16 * ((2 * d0 + hi) ^ (r32 & 7))); acc = __builtin_amdgcn_mfma_f32_32x32x16_bf16(ka, qr[qt][d0], acc, 0, 0, 0); }
            p[g] = acc; }
        v4u zz[2][2];
#pragma unroll
        for (int dh = 0; dh < 2; ++dh) { const GAS v4u* zp = (const GAS v4u*)(F.ZA + em * AW + head * HD + 32 * dh + ecol); zz[dh][0] = zp[0]; zz[dh][1] = zp[1]; }
#pragma unroll
        for (int r = 0; r < 16; ++r) { p[0][r] = (nb > 0 && CROW(r, hi) > r32) ? p[0][r] : -1e30f; p[4][r] = (CROW(r, hi) <= r32) ? p[4][r] : -1e30f; }
#pragma unroll
        for (int g = 1; g < 4; ++g) { if (nb == 0 && a + g < 4) {
#pragma unroll
            for (int r = 0; r < 16; ++r) p[g][r] = -1e30f; } }
        float mx = snk2;
#pragma unroll
        for (int g = 0; g < 5; ++g)
#pragma unroll
            for (int r = 0; r < 16; ++r) mx = fmaxf(mx, p[g][r]);
        mx = fmaxf(mx, __shfl_xor(mx, 32));
        float l = 0.f;
#pragma unroll
        for (int g = 0; g < 5; ++g)
#pragma unroll
            for (int r = 0; r < 16; ++r) { const float e = __builtin_amdgcn_exp2f(p[g][r] - mx); p[g][r] = e; l += e; }
        l += __shfl_xor(l, 32); l += __builtin_amdgcn_exp2f(snk2 - mx);
        if (hi == 0) lsc[r32] = __builtin_amdgcn_rcpf(l);
        f32x16 o[2]; o[0] = (f32x16){}; o[1] = (f32x16){};
#pragma unroll
        for (int g = 0; g < 5; ++g)
#pragma unroll
            for (int s = 0; s < 2; ++s) { const f32x16& P = p[g];
                const v4u pw = (v4u){pg8::cvt_pk_bf16(P[8 * s], P[8 * s + 1]), pg8::cvt_pk_bf16(P[8 * s + 2], P[8 * s + 3]), pg8::cvt_pk_bf16(P[8 * s + 4], P[8 * s + 5]), pg8::cvt_pk_bf16(P[8 * s + 6], P[8 * s + 7])};
                const bf16x8 pa = __builtin_bit_cast(bf16x8, pw);
                const int vrow = 32 * (a + g) + 16 * s + 4 * hi + ((lane & 15) >> 2), pp = lane & 3, h16 = (lane >> 4) & 1;
#pragma unroll
                for (int dh = 0; dh < 2; ++dh) { const int ch = 4 * dh + 2 * h16 + (pp >> 1);
                    const LAS unsigned char* v0p = L + L_V + vrow * 128 + 16 * (ch ^ (vrow & 7)) + 8 * (pp & 1);
                    const LAS unsigned char* v1p = L + L_V + (vrow + 8) * 128 + 16 * (ch ^ (vrow & 7)) + 8 * (pp & 1);
                    const s16x4 v0 = __builtin_bit_cast(s16x4, __builtin_amdgcn_ds_read_tr16_b64_v4i16((LAS v4i16_t*)v0p)), v1 = __builtin_bit_cast(s16x4, __builtin_amdgcn_ds_read_tr16_b64_v4i16((LAS v4i16_t*)v1p));
                    const bf16x8 vf = (bf16x8){v0[0], v0[1], v0[2], v0[3], v1[0], v1[1], v1[2], v1[3]};
                    o[dh] = __builtin_amdgcn_mfma_f32_32x32x16_bf16(pa, vf, o[dh], 0, 0, 0); } }
        LDS_WAIT();
        float rl[16];
#pragma unroll
        for (int r = 0; r < 16; ++r) rl[r] = lsc[CROW(r, hi)];
        float ssq = 0.f;
        const int erow = lane >> 1;
#pragma unroll
        for (int dh = 0; dh < 2; ++dh) {
#pragma unroll
            for (int r = 0; r < 16; ++r) stg[CROW(r, hi) * 36 + r32] = o[dh][r] * rl[r];
            LDS_WAIT();
            float z[16]; unpack8(zz[dh][0], z); unpack8(zz[dh][1], z + 8);
            float ov[16];
#pragma unroll
            for (int c4 = 0; c4 < 4; ++c4) { const f32x4 v = *(const LAS f32x4*)(stg + erow * 36 + ecol + 4 * c4);
#pragma unroll
                for (int e = 0; e < 4; ++e) { const float zv = z[4 * c4 + e]; const float val = v[e] * zv * pg8::sigmoidf_(zv); ov[4 * c4 + e] = val; ssq += val * val; } }
            GAS v4u* op = (GAS v4u*)(F.MG + em * 2048 + head * HD + 32 * dh + ecol);
            op[0] = (v4u){pg8::cvt_pk_bf16(ov[0], ov[1]), pg8::cvt_pk_bf16(ov[2], ov[3]), pg8::cvt_pk_bf16(ov[4], ov[5]), pg8::cvt_pk_bf16(ov[6], ov[7])}; op[1] = (v4u){pg8::cvt_pk_bf16(ov[8], ov[9]), pg8::cvt_pk_bf16(ov[10], ov[11]), pg8::cvt_pk_bf16(ov[12], ov[13]), pg8::cvt_pk_bf16(ov[14], ov[15])};
            LDS_WAIT();
        }
        ssq += __shfl_xor(ssq, 1);
        if ((lane & 1) == 0) F.rsq_a[em * 16 + head] = ssq;
    }
}
__device__ __forceinline__ void attn_phase(Frame& F, int rot = 0) {
    constexpr int NU = BATCH * 32 * NKV;
#pragma unroll 1
    for (int it0 = F.vcu; it0 < NU; it0 += F.G) { const int it = (it0 + rot) & (NU - 1); attn_unit(F, it >> 7, (it >> 2) & 31, it & 3); }
    __syncthreads();
}
#undef CROW
}
namespace ssm {
typedef short bf16x8 __attribute__((ext_vector_type(8)));
typedef float f32x16 __attribute__((ext_vector_type(16)));
typedef float f2 __attribute__((ext_vector_type(2)));
constexpr int L_WIN = 0, L_S = 0, SROW = 528, L_SIN = 67584, SINROW = 272, L_TF = 102400, L_TOT = 136192;
static_assert(L_SIN + 128 * SINROW <= L_TF && L_TF + 33792 <= L_TOT && L_TOT + 4 * 512 <= XP_OFF, "ssm LDS map");
#define CROW(r, hi) (((r) & 3) + 8 * ((r) >> 2) + 4 * (hi))
#define BARRIER() do { asm volatile("s_waitcnt vmcnt(0) lgkmcnt(0)" ::: "memory"); __builtin_amdgcn_s_barrier(); asm volatile("" ::: "memory"); } while (0)
#define LBARRIER() do { asm volatile("s_waitcnt lgkmcnt(0)" ::: "memory"); __builtin_amdgcn_s_barrier(); asm volatile("" ::: "memory"); } while (0)
__device__ __forceinline__ void cmul(float& ar, float& ai, float br, float bi) { const float t = ar * br - ai * bi; ai = ar * bi + ai * br; ar = t; }
__device__ __forceinline__ void ssm_unit(Frame& F, int b, int g) {
    const int tid = F.tid, lane = F.lane, wave = F.wave, r32 = lane & 31, hi = lane >> 5, nt = wave & 3, hw = wave >> 2;
    LAS unsigned char* L = F.lds + RING_OFF;
    const unsigned char* tb = F.ssmt + (size_t)g * SSM_GSTRIDE;
    LBARRIER();
    { const GAS v4u* wlp = (const GAS v4u*)(tb + SSM_OFF_WIN) + (wave * 1024 + lane);
#pragma unroll
      for (int k = 0; k < 16; ++k) __builtin_amdgcn_global_load_lds((const unsigned*)(wlp + k * 64), (LAS unsigned*)(L + L_WIN + (wave * 16 + k) * 1024), 16, 0, 0); }
    bf16x8 bu[32];
    { const GAS v4u* up = (const GAS v4u*)(F.U + ((size_t)(((b * 64 + g) * 4 + nt) * 32)) * 512) + lane;
#pragma unroll
      for (int i = 0; i < 32; ++i) bu[i] = __builtin_bit_cast(bf16x8, up[i * 64]); }
    BARRIER();
    f32x16 sa[2]; sa[0] = (f32x16){}; sa[1] = (f32x16){};
#pragma unroll
    for (int i = 0; i < 32; ++i)
#pragma unroll
        for (int pp = 0; pp < 2; ++pp) { const bf16x8 a = *(const LAS bf16x8*)(L + L_WIN + (((2 * hw + pp) * 32 + i) * 64 + lane) * 16); sa[pp] = __builtin_amdgcn_mfma_f32_32x32x16_bf16(a, bu[i], sa[pp], 0, 0, 0); }
    LBARRIER();
#pragma unroll
    for (int pp = 0; pp < 2; ++pp) { LAS unsigned char* sp = L + L_S + (32 * nt + r32) * SROW + (32 * (2 * hw + pp) + 4 * hi) * 4;
#pragma unroll
        for (int a4 = 0; a4 < 4; ++a4) *(LAS f32x4*)(sp + a4 * 32) = (f32x4){sa[pp][4 * a4], sa[pp][4 * a4 + 1], sa[pp][4 * a4 + 2], sa[pp][4 * a4 + 3]}; }
#pragma unroll
    for (int k = 0; k < 4; ++k) __builtin_amdgcn_global_load_lds((const unsigned*)((const GAS v4u*)(tb + SSM_OFF_T) + (wave * 4 + k) * 64 + lane), (LAS unsigned*)(L + L_TF + (wave * 4 + k) * 1024), 16, 0, 0);
    if (tid < 64) ((LAS v4u*)(L + L_TF + 32768))[tid] = (v4u){0u, 0u, 0u, 0u};
    BARRIER();
    const f2 w32 = *(const GAS f2*)(tb + SSM_OFF_W32 + lane * 8);
    if (wave < 4) { float sr = 0.f, si = 0.f;
#pragma unroll 1
        for (int jb = 0; jb < 4; ++jb) { float lr[8], li[8]; LAS unsigned char* row0 = L + L_S + (32 * wave + 8 * jb) * SROW + lane * 4;
#pragma unroll
            for (int j = 0; j < 8; ++j) { lr[j] = *(const LAS float*)(row0 + j * SROW); li[j] = *(const LAS float*)(row0 + j * SROW + 256); }
#pragma unroll
            for (int j = 0; j < 8; ++j) { *(LAS float*)(row0 + j * SROW) = sr; *(LAS float*)(row0 + j * SROW + 256) = si; const float nr = w32.x * sr - w32.y * si + lr[j]; si = w32.x * si + w32.y * sr + li[j]; sr = nr; } }
        *(LAS f2*)(L + L_TOT + wave * 512 + lane * 8) = (f2){sr, si};
    }
    LBARRIER();
    if (wave < 4) {
        float Wr = w32.x, Wi = w32.y;
#pragma unroll
        for (int q = 0; q < 5; ++q) cmul(Wr, Wi, Wr, Wi);
        float cr = 0.f, ci = 0.f;
        for (int m = 0; m < wave; ++m) { const f2 t = *(const LAS f2*)(L + L_TOT + m * 512 + lane * 8); cmul(cr, ci, Wr, Wi); cr += t.x; ci += t.y; }
#pragma unroll 1
        for (int jb = 0; jb < 4; ++jb) { float lr[8], li[8]; const LAS unsigned char* row0 = L + L_S + (32 * wave + 8 * jb) * SROW + lane * 4; LAS unsigned char* so0 = L + L_SIN + (32 * wave + 8 * jb) * SINROW + lane * 2;
#pragma unroll
            for (int j = 0; j < 8; ++j) { lr[j] = *(const LAS float*)(row0 + j * SROW); li[j] = *(const LAS float*)(row0 + j * SROW + 256); }
#pragma unroll
            for (int j = 0; j < 8; ++j) { *(LAS unsigned short*)(so0 + j * SINROW) = (unsigned short)f2bf(lr[j] + cr); *(LAS unsigned short*)(so0 + j * SINROW + 128) = (unsigned short)f2bf(li[j] + ci); cmul(cr, ci, w32.x, w32.y); } }
    }
    LBARRIER();
    v4u wo[8];
    { const GAS v4u* wp = (const GAS v4u*)(tb + SSM_OFF_WOUT + (size_t)((hw * 4) * 8) * 1024) + lane;
#pragma unroll
      for (int ks = 0; ks < 8; ++ks) wo[ks] = wp[ks * 64]; }
    const LAS unsigned char* sb = L + L_SIN + (32 * nt + r32) * SINROW + 16 * hi;
#pragma unroll 1
    for (int k = 0; k < 8; ++k) { const int rt = hw ? 4 + k : (k < 4 ? k : 8 + k); f32x16 acc = {};
#pragma unroll
        for (int ic = 0; ic < 8; ++ic) { if (4 * ic <= 2 * rt + 1) {
            bf16x8 a[4];
#pragma unroll
            for (int e = 0; e < 4; ++e) { const int dd = 2 * rt - (4 * ic + e) + 1; a[e] = *(const LAS bf16x8*)(L + L_TF + ((dd < 0 ? 32 : dd) * 64 + lane) * 16); }
#pragma unroll
            for (int e = 0; e < 4; ++e) acc = __builtin_amdgcn_mfma_f32_32x32x16_bf16(a[e], bu[4 * ic + e], acc, 0, 0, 0); } }
        const int rn = (k < 7) ? (hw ? 5 + k : (k < 3 ? k + 1 : 9 + k)) : rt; const GAS v4u* wpn = (const GAS v4u*)(tb + SSM_OFF_WOUT + (size_t)(rn * 8) * 1024) + lane;
#pragma unroll
        for (int ks = 0; ks < 8; ++ks) { const bf16x8 s = *(const LAS bf16x8*)(sb + 32 * ks); acc = __builtin_amdgcn_mfma_f32_32x32x16_bf16(__builtin_bit_cast(bf16x8, wo[ks]), s, acc, 0, 0, 0); wo[ks] = wpn[ks * 64]; }
        LAS unsigned char* stg = L + wave * 4608;
#pragma unroll
        for (int a4 = 0; a4 < 4; ++a4) { const unsigned lo = pg8::cvt_pk_bf16(gelu_tanh(acc[4 * a4]), gelu_tanh(acc[4 * a4 + 1])), hi2 = pg8::cvt_pk_bf16(gelu_tanh(acc[4 * a4 + 2]), gelu_tanh(acc[4 * a4 + 3]));
            *(LAS unsigned long long*)(stg + r32 * 144 + ((k & 1) * 2 + (a4 >> 1)) * 32 + (8 * (a4 & 1) + 4 * hi) * 2) = (unsigned long long)lo | ((unsigned long long)hi2 << 32); }
        if (k & 1) { bf16* yp = F.YG + ((size_t)g * M + (size_t)(b * SEQ + 32 * 32 * nt + 2 * (rt - 1))) * 16;
            asm volatile("s_waitcnt lgkmcnt(0)" ::: "memory");
#pragma unroll
            for (int i = 0; i < 4; ++i) { const int n = 8 * i + (lane >> 3), ch = lane & 7; const v4u v = *(const LAS v4u*)(stg + n * 144 + ch * 16); *(GAS v4u*)(yp + (size_t)n * 512 + ch * 8) = v; }
            asm volatile("s_waitcnt lgkmcnt(0)" ::: "memory"); } }
}
__device__ __forceinline__ void ssm_phase(Frame& F, int rot = 0) {
    for (int it0 = F.vcu; it0 < BATCH * SG; it0 += F.G) { const int it = (it0 + rot) & (BATCH * SG - 1); ssm_unit(F, it & 3, it >> 2); }
    LBARRIER();
}
#undef CROW
#undef BARRIER
#undef LBARRIER
}
struct Args { const void* in[20]; float* out; unsigned char* ws; int ph_lo, ph_hi, li, pad; };
__global__ void __launch_bounds__(NWAVES * 64, 2) hymba_fwd(Args args) {
    extern __shared__ __attribute__((aligned(16))) unsigned char lds[];
    Frame F;
    F.lds = (LAS unsigned char*)lds; F.MISC = (volatile LAS unsigned*)(F.lds + MISC_OFF);
    F.tid = threadIdx.x; F.lane = F.tid & 63; F.wave = __builtin_amdgcn_readfirstlane(F.tid >> 6);
    F.G = gridDim.x; { const int bx = blockIdx.x; F.vcu = (F.G % 8 == 0) ? (bx % 8) * (F.G / 8) + bx / 8 : bx; }
    unsigned char* ws = args.ws; F.ctl = (gu32*)(ws + WS_CTL);
    F.x = (const float*)args.in[0]; F.positions = (const int*)args.in[1]; F.norm_w = (const float*)args.in[2]; F.w_in = (const float*)args.in[3];
    F.q_norm_w = (const float*)args.in[4]; F.k_norm_w = (const float*)args.in[5]; F.sinks = (const float*)args.in[6];
    F.a_re = (const float*)args.in[7]; F.a_im = (const float*)args.in[8]; F.log_step = (const float*)args.in[9];
    F.b_re = (const float*)args.in[10]; F.b_im = (const float*)args.in[11]; F.c_re = (const float*)args.in[12]; F.c_im = (const float*)args.in[13];
    F.d_skip = (const float*)args.in[14]; F.w_glu = (const float*)args.in[15]; F.b_glu = (const float*)args.in[16];
    F.anw = (const float*)args.in[17]; F.snw = (const float*)args.in[18]; F.w_out = (const float*)args.in[19]; F.out = args.out;
    F.Win_t = (bf16*)(ws + WS_WIN); F.Wglu_t = (bf16*)(ws + WS_WGLU); F.Wout_t = (bf16*)(ws + WS_WOUT); F.XN = (bf16*)(ws + WS_XN);
    F.Q = (bf16*)(ws + WS_Q); F.KB = (bf16*)(ws + WS_K); F.VB = (bf16*)(ws + WS_V); F.ZA = (bf16*)(ws + WS_ZA); F.U = (bf16*)(ws + WS_U); F.ZS = (bf16*)(ws + WS_ZS);
    F.YG = (bf16*)(ws + WS_YG); F.MG = (bf16*)(ws + WS_MG);
    F.cos_t = (float*)(ws + WS_ROPE); F.sin_t = (float*)(ws + WS_ROPE + 2 * MiB); F.rsq_a = (float*)(ws + WS_RSQA); F.rsq_s = (float*)(ws + WS_RSQS); F.ssmt = ws + WS_SSMT;
    for (int u = F.tid; u < (LDS_BYTES - LDSCTL_OFF) / 4; u += NWAVES * 64) ((LAS unsigned*)(F.lds + LDSCTL_OFF))[u] = 0u;
    __syncthreads();
    XcdBarrier bar; bar.bar = (unsigned*)(F.ctl + CW_BAR); bar.x = 0; bar.st = nullptr;
    if (N_LAUNCHES != PER_PHASE) bar = xcd_barrier_post((unsigned*)(F.ctl + CW_BAR), F.MISC + 8);
#define GRID_BAR(seam) do { if (N_LAUNCHES == PER_PHASE) { if (F.tid == 0) __hip_atomic_store(F.ctl + CW_TMO, 0xBADBA0u | (unsigned)(seam), RLX_AGENT); } else { xcd_barrier(bar); } } while (0)
    const int lo = args.ph_lo, hi = args.ph_hi;
#define IN(k) (lo <= (k) && (k) < hi)
#define BOTH(k) (IN(k) && IN((k) + 1))

    if (IN(0)) { PAD_BEGIN(0); REPS(0) { p0_prologue(F); } PAD_END(0); if (BOTH(0)) GRID_BAR(0); }
    if (IN(1)) {
      PAD_BEGIN(1);
      REPS(1) {
        pg8::Gemm g{F.XN, F.Win_t, M, INW, DM}; pg8::StaticOrder S; S.init(M, INW, F.G, (int)blockIdx.x, WGM_P1, PNF_P1);
        pg8::EpiProj E{F.Q, F.KB, F.VB, F.ZA, F.U, F.ZS, F.cos_t, F.sin_t, F.q_norm_w, F.k_norm_w};
        pg8::gemm_phase<pg8::EpiProj, pg8::StaticOrder, true, true>(F.lds + RING_OFF, g, S, E);
      }
      { const int nwg = (M / 256) * (INW / 256), rem = nwg % F.G;
        REPS(10) { if (rem == 0) p0_deferred(F, (int)blockIdx.x, F.G); else if ((int)blockIdx.x >= rem) p0_deferred(F, (int)blockIdx.x - rem, F.G - rem); } }
        PAD_END(1);
        if (BOTH(1)) GRID_BAR(1);
    }
    if (IN(2)) {
        PAD_BEGIN(2);
        REPS(2) { ssm::ssm_phase(F); }
        PAD_END(2);
        if (BOTH(2)) GRID_BAR(2); }
    if (IN(3)) {
        PAD_BEGIN(3);
        pg8::Gemm g{F.YG, F.Wglu_t, M, SW, SW, 1}; pg8::StaticOrder S; S.init(M, SW, F.G, (int)blockIdx.x, WGM_P3, PNF_P3);
        pg8::EpiGlu E{F.YG, F.ZS, F.b_glu, F.MG, F.rsq_s};
        const bool gemm_first = (((F.vcu >> 4) + MIX_ROT) & 1) == 0;
        if (gemm_first) pg8::gemm_phase<pg8::EpiGlu, pg8::StaticOrder, true, true>(F.lds + RING_OFF, g, S, E);
        att::attn_phase(F);
        if (!gemm_first) pg8::gemm_phase<pg8::EpiGlu, pg8::StaticOrder, true, true>(F.lds + RING_OFF, g, S, E);
        __syncthreads();
        PAD_END(3);
        if (BOTH(3)) GRID_BAR(3);
    }
    if (IN(4)) {
      if (P4_SKEW_US > 0) { const unsigned long long t0 = __builtin_amdgcn_s_memrealtime(); const unsigned long long d = (unsigned long long)((F.vcu & 3) * P4_SKEW_US) * 100ull;
          while (__builtin_amdgcn_s_memrealtime() - t0 < d) __builtin_amdgcn_s_sleep(8); }
      REPS(4) {
        pg8::Gemm g{F.MG, F.Wout_t, M, DM, DM}; pg8::StaticOrder S; S.init(M, DM, F.G, (int)blockIdx.x, WGM_P4, PNF_P4);
        { typedef float f2 __attribute__((ext_vector_type(2))); LAS f2* tab = (LAS f2*)(F.lds + RING_OFF + TAB_OFF);
          for (int x = F.tid; x < 512; x += NWAVES * 64) { const int ui = x >> 8, r = x & 255; pg8::Unit u;
              if (S.next(ui, u)) { const int row = u.pm * 256 + r; const GAS f32x4* pa = (const GAS f32x4*)(F.rsq_a + (size_t)row * 16); const GAS f32x4* ps = (const GAS f32x4*)(F.rsq_s + (size_t)row * 16);
                  float sa = 0.f, ss = 0.f;
#pragma unroll
                  for (int j = 0; j < 4; ++j) { const f32x4 a = pa[j], s = ps[j]; sa += (a.x + a.y) + (a.z + a.w); ss += (s.x + s.y) + (s.z + s.w); }
                  const float ra = 1.0f / sqrtf(sa * (1.f / AW) + EPS), rs = 1.0f / sqrtf(ss * (1.f / SW) + EPS);
                  tab[x] = (f2){ra / rs, rs}; } }
          __syncthreads(); }
        pg8::EpiOut E{F.x, F.out};
        pg8::gemm_phase<pg8::EpiOut, pg8::StaticOrder, true, true>(F.lds + RING_OFF, g, S, E);
      }
    }
#undef IN
#undef BOTH
}

extern "C" void kernel_launch(void* const* d_in, const int* in_sizes, int n_in, void* d_out, int out_size, void* d_ws, size_t ws_size, hipStream_t stream) {
    static int grid = 0;
    if (grid == 0) {
        if (n_in != 20 || in_sizes[0] != M * DM || out_size != M * DM || ws_size < WS_END) { fprintf(stderr, "kernel_launch: unexpected shapes (n_in %d, in0 %d, out %d, ws %zu); nothing launched\n", n_in, n_in > 0 ? in_sizes[0] : -1, out_size, ws_size); grid = -1; return; }
        int dev = 0, cus = 0, per_cu = 0;
        if (hipGetDevice(&dev) != hipSuccess || hipDeviceGetAttribute(&cus, hipDeviceAttributeMultiprocessorCount, dev) != hipSuccess) { grid = -1; return; }
        if (hipFuncSetAttribute((const void*)hymba_fwd, hipFuncAttributeMaxDynamicSharedMemorySize, LDS_BYTES) != hipSuccess) { fprintf(stderr, "kernel_launch: hipFuncSetAttribute failed\n"); grid = -1; return; }
        if (hipOccupancyMaxActiveBlocksPerMultiprocessor(&per_cu, (const void*)hymba_fwd, NWAVES * 64, LDS_BYTES) != hipSuccess || per_cu < 1) fprintf(stderr, "kernel_launch: occupancy query reports %d workgroups per CU\n", per_cu);
        (void)hipGetLastError();
        grid = cus;
    }
    if (grid < 0) return;
    if (hipMemsetAsync((char*)d_ws + WS_CTL, 0, CTL_ZERO_BYTES, stream) != hipSuccess) { fprintf(stderr, "kernel_launch: hipMemsetAsync failed\n"); return; }
    Args a{};
    for (int i = 0; i < 20; ++i) a.in[i] = d_in[i];
    a.out = (float*)d_out; a.ws = (unsigned char*)d_ws;
    for (int li = 0; li < N_LAUNCHES; ++li) {
        a.ph_lo = (N_LAUNCHES == PER_PHASE) ? li : 0; a.ph_hi = (N_LAUNCHES == PER_PHASE) ? li + 1 : PER_PHASE; a.li = li;
        hipLaunchKernelGGL(hymba_fwd, dim3(grid), dim3(NWAVES * 64), LDS_BYTES, stream, a);
        const hipError_t le = hipPeekAtLastError();
        if (le != hipSuccess) { fprintf(stderr, "kernel_launch: launch %d failed: %s\n", li, hipGetErrorName(le)); break; }
    }
}
```
